# Optimizing an MI355X kernel written in HIP

```python
import jax, jax.numpy as jnp
from jax import lax
import numpy as np

D_MODEL = 1024
BATCH = 32
SEQ = 2048
DEPTH = 4

N_MIXERS = 3
HEAD_DIM = 64
N_HEADS = D_MODEL // HEAD_DIM
MIX_WIDTH = N_HEADS * HEAD_DIM
Q_BLOCK = 128
ROPE_THETA = 10000.0
NEG_INF = -1e30
PLE_DIM = 256
MAX_POS_OFFSET = 4096
DEEPNORM_ALPHA = (2 * DEPTH) ** 0.25
DEEPNORM_BETA = (8 * DEPTH) ** -0.25
LN_EPS = 1e-5
RMS_EPS = 1e-6

SWA_WINDOW = 128
SWA_KV_HEADS = 4
SWA_GROUP = N_HEADS // SWA_KV_HEADS
SWA_KV = SWA_KV_HEADS * HEAD_DIM
SWA_IN = MIX_WIDTH + 2 * SWA_KV + MIX_WIDTH

MLA_Q_LORA = 384
MLA_KV_LORA = 256
MLA_NOPE = 64
MLA_ROPE = 32
MLA_V = 64
MLA_IN = MLA_Q_LORA + MLA_KV_LORA + MLA_ROPE + MIX_WIDTH

NSA_KV_GROUPS = 4
NSA_GROUP = N_HEADS // NSA_KV_GROUPS
NSA_KV = NSA_KV_GROUPS * HEAD_DIM
CMP_BLOCK = 32
CMP_STRIDE = 16
SEL_BLOCK = 64
N_SEL = 8
SEL_Q_BLOCK = 32
SEL_FORCE = 1e9
NSA_WINDOW = 512
PHI_HIDDEN = 256
NSA_IN = MIX_WIDTH + 6 * NSA_KV + 3 * N_HEADS + MIX_WIDTH

kernel_name = 'hybrid_swa_mla_nsa_deepnorm'


def _layernorm(x, g, b):
    xf = x.astype(jnp.float32)
    mu = xf.mean(-1, keepdims=True)
    var = jnp.square(xf - mu).mean(-1, keepdims=True)
    return ((xf - mu) * lax.rsqrt(var + LN_EPS) * g + b).astype(x.dtype)


def _rmsnorm(x, g):
    xf = x.astype(jnp.float32)
    return (xf * lax.rsqrt(jnp.mean(xf * xf, -1, keepdims=True) + RMS_EPS) * g).astype(x.dtype)


def _rope(x, pos):
    half = x.shape[-1] // 2
    inv = ROPE_THETA ** (-jnp.arange(half, dtype=jnp.float32) / half)
    ang = pos.astype(jnp.float32)[..., None] * inv
    cos = jnp.cos(ang)[:, :, None, :]
    sin = jnp.sin(ang)[:, :, None, :]
    x1 = x[..., :half].astype(jnp.float32)
    x2 = x[..., half:].astype(jnp.float32)
    return jnp.concatenate([x1 * cos - x2 * sin, x2 * cos + x1 * sin], -1).astype(x.dtype)


def _banded_gqa(q, k, v, window, sinks):
    B, S, G, R, D = q.shape
    nb = S // Q_BLOCK
    n_prev = -(-(window - 1) // Q_BLOCK)
    span = (n_prev + 1) * Q_BLOCK
    pad = n_prev * Q_BLOCK
    kp = jnp.pad(k, ((0, 0), (pad, 0), (0, 0), (0, 0)))
    vp = jnp.pad(v, ((0, 0), (pad, 0), (0, 0), (0, 0)))
    qb = q.reshape(B, nb, Q_BLOCK, G, R, D).transpose(1, 0, 2, 3, 4, 5)
    scale = D ** -0.5

    def blk(args):
        b, qblk = args
        start = b * Q_BLOCK
        kb = lax.dynamic_slice_in_dim(kp, start, span, axis=1)
        vb = lax.dynamic_slice_in_dim(vp, start, span, axis=1)
        t = start + jnp.arange(Q_BLOCK)
        j = start - pad + jnp.arange(span)
        mask = (j[None, :] <= t[:, None]) & (j[None, :] > t[:, None] - window) & (j[None, :] >= 0)
        s = jnp.einsum('bqgrd,bkgd->bgrqk', qblk, kb).astype(jnp.float32) * scale
        s = jnp.where(mask, s, NEG_INF)
        if sinks is None:
            pr = jax.nn.softmax(s, axis=-1)
        else:
            snk = jnp.broadcast_to(sinks.astype(jnp.float32).reshape(1, G, R, 1, 1), s.shape[:-1] + (1,))
            pr = jax.nn.softmax(jnp.concatenate([s, snk], -1), axis=-1)[..., :-1]
        return jnp.einsum('bgrqk,bkgd->bqgrd', pr.astype(vb.dtype), vb)

    ob = lax.map(blk, (jnp.arange(nb), qb))
    return ob.transpose(1, 0, 2, 3, 4, 5).reshape(B, S, G, R, D)


def _mla_attention(q_nope, q_rope, k_nope, k_rope, v):
    B, S, H, Dn = q_nope.shape
    Dr = q_rope.shape[-1]
    nb = S // Q_BLOCK
    scale = (Dn + Dr) ** -0.5
    qn = q_nope.reshape(B, nb, Q_BLOCK, H, Dn).transpose(1, 0, 2, 3, 4)
    qr = q_rope.reshape(B, nb, Q_BLOCK, H, Dr).transpose(1, 0, 2, 3, 4)
    kpos = jnp.arange(S)

    def blk(args):
        b, qnb, qrb = args
        t = b * Q_BLOCK + jnp.arange(Q_BLOCK)
        s = (jnp.einsum('bqhd,bkhd->bhqk', qnb, k_nope)
             + jnp.einsum('bqhd,bkd->bhqk', qrb, k_rope)).astype(jnp.float32) * scale
        pr = jax.nn.softmax(jnp.where(kpos[None, :] <= t[:, None], s, NEG_INF), axis=-1)
        return jnp.einsum('bhqk,bkhd->bqhd', pr.astype(v.dtype), v)

    ob = lax.map(blk, (jnp.arange(nb), qn, qr))
    return ob.transpose(1, 0, 2, 3, 4).reshape(B, S, H, v.shape[-1])


def _selected_attention(q, k, v, sel):
    B, S, G, R, D = q.shape
    K = sel.shape[-1]
    n_blk = S // SEL_BLOCK
    nq = S // SEL_Q_BLOCK
    scale = D ** -0.5
    kb = k.reshape(B, n_blk, SEL_BLOCK, G, D).transpose(0, 3, 1, 2, 4)
    vb = v.reshape(B, n_blk, SEL_BLOCK, G, D).transpose(0, 3, 1, 2, 4)
    qb = q.reshape(B, nq, SEL_Q_BLOCK, G, R, D).transpose(1, 0, 2, 3, 4, 5)
    ib = sel.reshape(B, G, nq, SEL_Q_BLOCK, K).transpose(2, 0, 1, 3, 4)
    gather = jax.vmap(jax.vmap(lambda blocks, ids: blocks[ids]))
    offs = jnp.arange(SEL_BLOCK)

    def blk(args):
        b, qblk, iblk = args
        t = b * SEL_Q_BLOCK + jnp.arange(SEL_Q_BLOCK)
        kg = gather(kb, iblk).reshape(B, G, SEL_Q_BLOCK, K * SEL_BLOCK, D)
        vg = gather(vb, iblk).reshape(B, G, SEL_Q_BLOCK, K * SEL_BLOCK, D)
        kpos = (iblk[..., None] * SEL_BLOCK + offs).reshape(B, G, SEL_Q_BLOCK, K * SEL_BLOCK)
        mask = (kpos <= t[None, None, :, None])[:, :, None]
        s = jnp.einsum('bqgrd,bgqkd->bgrqk', qblk, kg).astype(jnp.float32) * scale
        pr = jax.nn.softmax(jnp.where(mask, s, NEG_INF), axis=-1)
        return jnp.einsum('bgrqk,bgqkd->bqgrd', pr.astype(vg.dtype), vg)

    ob = lax.map(blk, (jnp.arange(nq), qb, ib))
    return ob.transpose(1, 0, 2, 3, 4, 5).reshape(B, S, G, R, D)


def _mixer_swa(h, positions, w_in, sinks):
    B, S, _ = h.shape
    proj = h @ w_in
    q, k, v, z = jnp.split(proj, [MIX_WIDTH, MIX_WIDTH + SWA_KV, MIX_WIDTH + 2 * SWA_KV], axis=-1)
    q = _rope(q.reshape(B, S, N_HEADS, HEAD_DIM), positions).reshape(B, S, SWA_KV_HEADS, SWA_GROUP, HEAD_DIM)
    k = _rope(k.reshape(B, S, SWA_KV_HEADS, HEAD_DIM), positions)
    v = v.reshape(B, S, SWA_KV_HEADS, HEAD_DIM)
    o = _banded_gqa(q, k, v, SWA_WINDOW, sinks).reshape(B, S, MIX_WIDTH)
    return o * jax.nn.silu(z)


def _mixer_mla(h, positions, w_in, q_norm, kv_norm, w_uq, w_ukv):
    B, S, _ = h.shape
    proj = h @ w_in
    cq, ckv, kr, z = jnp.split(proj, [MLA_Q_LORA, MLA_Q_LORA + MLA_KV_LORA,
                                      MLA_Q_LORA + MLA_KV_LORA + MLA_ROPE], axis=-1)
    q = (_rmsnorm(cq, q_norm) @ w_uq).reshape(B, S, N_HEADS, MLA_NOPE + MLA_ROPE)
    q_nope = q[..., :MLA_NOPE]
    q_rope = _rope(q[..., MLA_NOPE:], positions)
    kv = (_rmsnorm(ckv, kv_norm) @ w_ukv).reshape(B, S, N_HEADS, MLA_NOPE + MLA_V)
    k_nope = kv[..., :MLA_NOPE]
    v = kv[..., MLA_NOPE:]
    k_rope = _rope(kr[:, :, None, :], positions)[:, :, 0, :]
    o = _mla_attention(q_nope, q_rope, k_nope, k_rope, v).reshape(B, S, MIX_WIDTH)
    return o * jax.nn.silu(z)


def _mixer_nsa(h, positions, w_in, cmp_pos, phi_k1, phi_k2, phi_v1, phi_v2):
    B, S, _ = h.shape
    G, R, D = NSA_KV_GROUPS, NSA_GROUP, HEAD_DIM
    proj = h @ w_in
    cuts = np.cumsum([MIX_WIDTH] + [NSA_KV] * 6 + [3 * N_HEADS]).tolist()
    q, k_c, v_c, k_s, v_s, k_w, v_w, gl, z = jnp.split(proj, cuts, axis=-1)
    q = _rope(q.reshape(B, S, N_HEADS, D), positions).reshape(B, S, G, R, D)
    scale = D ** -0.5
    t_idx = jnp.arange(S)

    n_cmp = (S - CMP_BLOCK) // CMP_STRIDE + 1
    tok = jnp.arange(n_cmp)[:, None] * CMP_STRIDE + jnp.arange(CMP_BLOCK)[None, :]

    def compress(t, w1, w2):
        blocks = t.reshape(B, S, G, D)[:, tok] + cmp_pos[:, None, :]
        flat = blocks.transpose(0, 1, 3, 2, 4).reshape(B, n_cmp, G, CMP_BLOCK * D)
        return jax.nn.silu(flat @ w1) @ w2

    blk_end = tok[:, -1]
    kc = _rope(compress(k_c, phi_k1, phi_k2), positions[:, blk_end])
    vc = compress(v_c, phi_v1, phi_v2)
    cmask = blk_end[None, :] <= t_idx[:, None]
    sc = jnp.einsum('bsgrd,bngd->bgrsn', q, kc).astype(jnp.float32) * scale
    pc = jnp.where(cmask, jax.nn.softmax(jnp.where(cmask, sc, NEG_INF), axis=-1), 0.0)
    o_cmp = jnp.einsum('bgrsn,bngd->bsgrd', pc.astype(vc.dtype), vc)

    n_blk = S // SEL_BLOCK
    n_top = min(N_SEL, n_blk)
    j = jnp.arange(n_blk)
    cstart = tok[:, 0]
    overlap = ((cstart[:, None] < (j[None, :] + 1) * SEL_BLOCK)
               & (cstart[:, None] + CMP_BLOCK > j[None, :] * SEL_BLOCK)).astype(jnp.float32)
    imp = jnp.einsum('bgrsn,nj->bgsj', pc, overlap)
    cur = (t_idx // SEL_BLOCK)[:, None]
    forced = (j[None, :] == 0) | (j[None, :] == cur) | (j[None, :] == cur - 1)
    score = jnp.where(forced, SEL_FORCE, jnp.where(j[None, :] <= cur, imp, -SEL_FORCE))
    _, sel = lax.top_k(score, n_top)
    ks = _rope(k_s.reshape(B, S, G, D), positions)
    o_slc = _selected_attention(q, ks, v_s.reshape(B, S, G, D), sel)

    kw = _rope(k_w.reshape(B, S, G, D), positions)
    o_win = _banded_gqa(q, kw, v_w.reshape(B, S, G, D), NSA_WINDOW, None)

    g = jax.nn.sigmoid(gl.astype(jnp.float32)).astype(h.dtype).reshape(B, S, 3, G, R, 1)
    o = g[:, :, 0] * o_cmp + g[:, :, 1] * o_slc + g[:, :, 2] * o_win
    return o.reshape(B, S, MIX_WIDTH) * jax.nn.silu(z)


def setup_inputs(seed: int = 0) -> dict:
    key = jax.random.key(seed)
    ks = list(jax.random.split(key, 40))

    def nrm(shape, scale):
        return jax.random.normal(ks.pop(), shape, jnp.float32) * scale

    def gain(shape):
        return 1.0 + nrm(shape, 0.02)

    x = nrm((BATCH, SEQ, D_MODEL), 1.0)
    p = nrm((DEPTH, BATCH, SEQ, PLE_DIM), 1.0)
    positions = (jax.random.randint(ks.pop(), (BATCH, 1), 0, MAX_POS_OFFSET, dtype=jnp.int32)
                 + jnp.arange(SEQ, dtype=jnp.int32)[None, :]).astype(jnp.int32)
    return {
        'x': x,
        'p': p,
        'positions': positions,
        'w_out': nrm((DEPTH, MIX_WIDTH, D_MODEL), MIX_WIDTH ** -0.5 * DEEPNORM_BETA),
        'ln_g': gain((DEPTH, D_MODEL)),
        'ln_b': nrm((DEPTH, D_MODEL), 0.02),
        'pe_gate': nrm((DEPTH, D_MODEL, D_MODEL), D_MODEL ** -0.5),
        'pe_proj': nrm((DEPTH, PLE_DIM, D_MODEL), PLE_DIM ** -0.5),
        'l0_w_in': nrm((D_MODEL, SWA_IN), D_MODEL ** -0.5),
        'l0_sinks': nrm((N_HEADS,), 0.5),
        'l1_w_in': nrm((D_MODEL, MLA_IN), D_MODEL ** -0.5),
        'l1_q_norm': gain((MLA_Q_LORA,)),
        'l1_kv_norm': gain((MLA_KV_LORA,)),
        'l1_w_uq': nrm((MLA_Q_LORA, N_HEADS * (MLA_NOPE + MLA_ROPE)), MLA_Q_LORA ** -0.5),
        'l1_w_ukv': nrm((MLA_KV_LORA, N_HEADS * (MLA_NOPE + MLA_V)), MLA_KV_LORA ** -0.5),
        'l2_w_in': nrm((D_MODEL, NSA_IN), D_MODEL ** -0.5),
        'l2_cmp_pos': nrm((CMP_BLOCK, HEAD_DIM), 0.1),
        'l2_phi_k1': nrm((CMP_BLOCK * HEAD_DIM, PHI_HIDDEN), (CMP_BLOCK * HEAD_DIM) ** -0.5),
        'l2_phi_k2': nrm((PHI_HIDDEN, HEAD_DIM), PHI_HIDDEN ** -0.5),
        'l2_phi_v1': nrm((CMP_BLOCK * HEAD_DIM, PHI_HIDDEN), (CMP_BLOCK * HEAD_DIM) ** -0.5),
        'l2_phi_v2': nrm((PHI_HIDDEN, HEAD_DIM), PHI_HIDDEN ** -0.5),
        'l3_w_in': nrm((D_MODEL, SWA_IN), D_MODEL ** -0.5),
        'l3_sinks': nrm((N_HEADS,), 0.5),
    }


def reference(x, p, positions, w_out, ln_g, ln_b, pe_gate, pe_proj,
              l0_w_in, l0_sinks,
              l1_w_in, l1_q_norm, l1_kv_norm, l1_w_uq, l1_w_ukv,
              l2_w_in, l2_cmp_pos, l2_phi_k1, l2_phi_k2, l2_phi_v1, l2_phi_v2,
              l3_w_in, l3_sinks):
    mixers = (_mixer_swa, _mixer_mla, _mixer_nsa)
    layer_params = (
        (l0_w_in, l0_sinks),
        (l1_w_in, l1_q_norm, l1_kv_norm, l1_w_uq, l1_w_ukv),
        (l2_w_in, l2_cmp_pos, l2_phi_k1, l2_phi_k2, l2_phi_v1, l2_phi_v2),
        (l3_w_in, l3_sinks),
    )
    for i in range(DEPTH):
        y = mixers[i % N_MIXERS](x, positions, *layer_params[i]) @ w_out[i]
        x = _layernorm(DEEPNORM_ALPHA * x + y, ln_g[i], ln_b[i])
        x = x + jax.nn.sigmoid(x @ pe_gate[i]) * (p[i] @ pe_proj[i])
    return x
```

```cpp
#include <hip/hip_runtime.h>
#include <hip/hip_cooperative_groups.h>
#include <stdint.h>
#include <stdio.h>
namespace cg = cooperative_groups;

typedef __attribute__((ext_vector_type(8))) short bf16x8;
typedef __attribute__((ext_vector_type(16))) float f32x16;
typedef __attribute__((ext_vector_type(2))) float f32x2_t;
typedef __attribute__((ext_vector_type(2))) __bf16 bf16x2_t;
typedef unsigned short bf16_t;

#define DI __device__ __forceinline__
#define MFMA(a, b, c) __builtin_amdgcn_mfma_f32_32x32x16_bf16((a), (b), (c), 0, 0, 0)

constexpr int SEQ = 2048;
constexpr int NB = 32;
constexpr int MTOK = NB * SEQ;
constexpr int DM = 1024;
constexpr float LOG2E = 1.4426950408889634f;
constexpr float NEGF = -1e30f;
constexpr float DN_ALPHA = 1.681792830507429f;

constexpr size_t al256(size_t x) { return (x + 255) & ~(size_t)255; }
constexpr size_t OFF_WIN0T = 0;
constexpr size_t OFF_WIN1T = OFF_WIN0T + (size_t)2560 * 1024 * 2;
constexpr size_t OFF_WIN2T = OFF_WIN1T + (size_t)1792 * 1024 * 2;
constexpr size_t OFF_WIN3T = OFF_WIN2T + (size_t)3840 * 1024 * 2;
constexpr size_t OFF_WUQT = OFF_WIN3T + (size_t)2560 * 1024 * 2;
constexpr size_t OFF_WUKVT = OFF_WUQT + (size_t)1536 * 384 * 2;
constexpr size_t OFF_PK1T = OFF_WUKVT + (size_t)2048 * 256 * 2;
constexpr size_t OFF_PV1T = OFF_PK1T + (size_t)256 * 2048 * 2;
constexpr size_t OFF_PK2T = OFF_PV1T + (size_t)256 * 2048 * 2;
constexpr size_t OFF_PV2T = OFF_PK2T + (size_t)256 * 256 * 2;
constexpr size_t OFF_WOUTT = OFF_PV2T + (size_t)256 * 256 * 2;
constexpr size_t OFF_PGT = OFF_WOUTT + (size_t)4 * 1024 * 1024 * 2;
constexpr size_t OFF_PPT = OFF_PGT + (size_t)4 * 1024 * 1024 * 2;
constexpr size_t OFF_C1 = OFF_PPT + (size_t)4 * 1024 * 256 * 2;
constexpr size_t OFF_C2 = OFF_C1 + 4 * 1024 * 4;
constexpr size_t OFF_BIAS = OFF_C2 + 4 * 1024 * 4;
constexpr size_t OFF_CS64 = OFF_BIAS + 2 * 256 * 4;
constexpr size_t OFF_CS32 = OFF_CS64 + (size_t)MTOK * 32 * 8;
constexpr size_t OFF_STATS = OFF_CS32 + (size_t)MTOK * 16 * 8;
constexpr size_t OFF_MSTAT = OFF_STATS + (size_t)MTOK * 32 * 4;
constexpr size_t OFF_XB = OFF_MSTAT + (size_t)MTOK * 16 * 4;
constexpr size_t OFF_BIG = OFF_XB + (size_t)MTOK * 1024 * 2;
constexpr size_t BIG_ELEMS = (size_t)MTOK * 5280;
constexpr size_t OFF_BAR = OFF_BIG + BIG_ELEMS * 2 + 65536;
constexpr size_t OFF_PB = OFF_BAR + 16384;
constexpr size_t WS_NEED = OFF_PB + (size_t)4 * MTOK * 256 * 2;

constexpr size_t MK = MTOK;
constexpr size_t BG_PP = MK * 1024;
constexpr size_t SW_Q = 0, SW_K = MK * 1024, SW_VT = MK * 1280, SW_Z = MK * 1536;
constexpr size_t ML_CQ = 0, ML_CKV = MK * 384, ML_Z = MK * 640, ML_KR = MK * 1664, ML_QN = MK * 1696, ML_QR = MK * 2720,
                 ML_KN = MK * 3232, ML_VT = MK * 4256;
constexpr size_t NS_Q = 0, NS_KCR = MK * 1024, NS_VCR = MK * 1280, NS_KS = MK * 1536, NS_VST = MK * 1792, NS_KW = MK * 2048,
                 NS_VWT = MK * 2304, NS_Z = MK * 2560, NS_GL = MK * 3584, NS_HK = MK * 3648, NS_HV = MK * 3712,
                 NS_KC2 = MK * 3776, NS_VCT = MK * 3792;

constexpr int NTHR = 512;
constexpr int LDS_TILE = 256 * 72;
constexpr int LDS_GEMM_BYTES = 4 * LDS_TILE * 2;
constexpr int LDS_ROW_OFF = LDS_GEMM_BYTES;
constexpr int LDS_VEC_OFF = LDS_GEMM_BYTES + 2048;
constexpr int LDS_BYTES = LDS_GEMM_BYTES + 2048 + 4096;
constexpr int ATT_LDS = 73728;

struct Params {
  const float* x; const float* p; const int* pos; const float* w_out; const float* ln_g; const float* ln_b;
  const float* pe_gate; const float* pe_proj;
  const float* l0_w_in; const float* l0_sinks;
  const float* l1_w_in; const float* l1_q_norm; const float* l1_kv_norm; const float* l1_w_uq; const float* l1_w_ukv;
  const float* l2_w_in; const float* l2_cmp_pos; const float* l2_phi_k1; const float* l2_phi_k2; const float* l2_phi_v1; const float* l2_phi_v2;
  const float* l3_w_in; const float* l3_sinks;
  float* out; unsigned char* ws;
};

DI unsigned pack2(float a, float b) { f32x2_t v = {a, b}; bf16x2_t r = __builtin_convertvector(v, bf16x2_t); return __builtin_bit_cast(unsigned, r); }
DI bf16_t f2bf(float a) { return (bf16_t)(pack2(a, 0.f) & 0xffffu); }
DI float bf2f(bf16_t b) { return __uint_as_float(((unsigned)b) << 16); }
DI float bflo(unsigned u) { return __uint_as_float(u << 16); }
DI float bfhi(unsigned u) { return __uint_as_float(u & 0xffff0000u); }
DI float fexp2(float x) { return __builtin_amdgcn_exp2f(x); }
DI float sigmoidf_(float x) { return __builtin_amdgcn_rcpf(1.f + __expf(-x)); }
DI float siluf_(float x) { return x * __builtin_amdgcn_rcpf(1.f + __expf(-x)); }
DI int crow(int reg, int h) { return (reg & 3) + 8 * (reg >> 2) + 4 * h; }
DI float shx(float v, int m) { return __shfl_xor(v, m, 64); }
DI int otid() { int t = threadIdx.x; asm volatile("" : "+v"(t)); return t; }

DI float rowsum16(const float (&v)[16], int c) {
  float w8[8], w4[4], w2[2];
  const bool b4 = c & 16, b3 = c & 8, b2 = c & 4, b1 = c & 2;
#pragma unroll
  for (int k = 0; k < 8; ++k) { float send = b4 ? v[k] : v[k + 8]; float keep = b4 ? v[k + 8] : v[k]; w8[k] = keep + shx(send, 16); }
#pragma unroll
  for (int k = 0; k < 4; ++k) { float send = b3 ? w8[k] : w8[k + 4]; float keep = b3 ? w8[k + 4] : w8[k]; w4[k] = keep + shx(send, 8); }
#pragma unroll
  for (int k = 0; k < 2; ++k) { float send = b2 ? w4[k] : w4[k + 2]; float keep = b2 ? w4[k + 2] : w4[k]; w2[k] = keep + shx(send, 4); }
  float send = b1 ? w2[0] : w2[1]; float keep = b1 ? w2[1] : w2[0];
  float w1 = keep + shx(send, 2);
  return w1 + shx(w1, 1);
}
DI int rowsum_idx(int c) { return ((c >> 4) & 1) * 8 + ((c >> 3) & 1) * 4 + ((c >> 2) & 1) * 2 + ((c >> 1) & 1); }

struct ARowPlain { const bf16_t* A; int lda; DI const bf16_t* operator()(int row, int kt) const { return A + (size_t)row * lda + kt * 64; } };
struct ARowF32 { const float* A; int lda; DI const float* operator()(int row, int kt) const { return A + (size_t)row * lda + kt * 64; } };
struct ARowCmp { const bf16_t* base; DI const bf16_t* operator()(int row, int kt) const {
  int b = row >> 9, n = (row >> 2) & 127, g = row & 3; return base + ((size_t)(b * SEQ + n * 16 + kt)) * 256 + g * 64; } };

typedef unsigned u32x4 __attribute__((ext_vector_type(4)));
typedef float f32x4 __attribute__((ext_vector_type(4)));
DI u32x4 ldg16(const void* p) { return *(const u32x4*)p; }
DI void stg16_nt(void* p, u32x4 v) { __builtin_nontemporal_store(v, (u32x4*)p); }
DI f32x4 ldgf4(const float* p) { return *(const f32x4*)p; }
DI u32x4 cvt8(f32x4 a, f32x4 b) { u32x4 r; r.x = pack2(a.x, a.y); r.y = pack2(a.z, a.w); r.z = pack2(b.x, b.y); r.w = pack2(b.z, b.w); return r; }

struct GR { u32x4 a0, a1, a2, a3, b0, b1, b2, b3; };
#define GL_LOADA(i, kt) { R.a##i = ldg16((const bf16_t*)ar(m0 + lrow + 64 * i, kt) + lkc * 8); \
                          R.b##i = ldg16(Bt + (size_t)(n0 + lrow + 64 * i) * ldb + (kt) * 64 + lkc * 8); }
#define GL_STORE(i) { *(u32x4*)(sA + (lrow + 64 * i) * 72 + lkc * 8) = R.a##i; *(u32x4*)(sB + (lrow + 64 * i) * 72 + lkc * 8) = R.b##i; }

template <bool AF32, class AR>
DI void gemm_first(GR& R, const AR& ar, const bf16_t* __restrict__ Bt, int ldb, int m0, int n0) {
  const int tid = otid();
  const int lrow = tid >> 3, lkc = tid & 7;
  GL_LOADA(0, 0) GL_LOADA(1, 0) GL_LOADA(2, 0) GL_LOADA(3, 0)
}

template <bool AF32, class AR>
DI void gemm_loop(f32x16 (&acc)[4][2], GR& R, const AR& ar, const bf16_t* __restrict__ Bt, int ldb, int m0, int n0, int nk, bf16_t* lds, bool swp) {
  const int tid = otid();
  const int lane = tid & 63, w = tid >> 6, r = lane & 31, h = lane >> 5;
  const int wm = w >> 2, wn = w & 3;
  const int lrow = tid >> 3, lkc = tid & 7;
  for (int kt = 0; kt < nk; ++kt) {
    bf16_t* sA = lds + (kt & 1) * LDS_TILE;
    bf16_t* sB = lds + 2 * LDS_TILE + (kt & 1) * LDS_TILE;
    GL_STORE(0) GL_STORE(1) GL_STORE(2) GL_STORE(3)
    __syncthreads();
    if (kt + 1 < nk) { GL_LOADA(0, kt + 1) GL_LOADA(1, kt + 1) GL_LOADA(2, kt + 1) GL_LOADA(3, kt + 1) }
    __builtin_amdgcn_sched_barrier(0);
    {
      const bf16_t* pa = (swp ? sB : sA) + (wm * 128 + r) * 72 + 8 * h;
      const bf16_t* pb = (swp ? sA : sB) + (wn * 64 + r) * 72 + 8 * h;
#define FR_LOAD(ks, P) { P##a0 = *(const bf16x8*)(pa + (ks) * 16); P##a1 = *(const bf16x8*)(pa + 32 * 72 + (ks) * 16); \
                         P##a2 = *(const bf16x8*)(pa + 64 * 72 + (ks) * 16); P##a3 = *(const bf16x8*)(pa + 96 * 72 + (ks) * 16); \
                         P##b0 = *(const bf16x8*)(pb + (ks) * 16); P##b1 = *(const bf16x8*)(pb + 32 * 72 + (ks) * 16); }
#define FR_MMA(P) { acc[0][0] = MFMA(P##a0, P##b0, acc[0][0]); acc[0][1] = MFMA(P##a0, P##b1, acc[0][1]); \
                    acc[1][0] = MFMA(P##a1, P##b0, acc[1][0]); acc[1][1] = MFMA(P##a1, P##b1, acc[1][1]); \
                    acc[2][0] = MFMA(P##a2, P##b0, acc[2][0]); acc[2][1] = MFMA(P##a2, P##b1, acc[2][1]); \
                    acc[3][0] = MFMA(P##a3, P##b0, acc[3][0]); acc[3][1] = MFMA(P##a3, P##b1, acc[3][1]); }
#pragma unroll
      for (int ks = 0; ks < 4; ++ks) {
        bf16x8 xa0, xa1, xa2, xa3, xb0, xb1;
        FR_LOAD(ks, x)
        FR_MMA(x)
      }
    }
  }
  __syncthreads();
}

DI void acc_zero(f32x16 (&acc)[4][2]) {
#pragma unroll
  for (int i = 0; i < 4; ++i)
#pragma unroll
    for (int j = 0; j < 2; ++j)
#pragma unroll
      for (int q = 0; q < 16; ++q) acc[i][j][q] = 0.f;
}

enum { K_PLAIN = 0, K_ROPE64 = 1, K_ROPE32 = 2, K_VT = 3, K_SILU = 4, K_KC2 = 5, K_VCT = 6, K_NONE = 7 };
struct Seg {
  int kind; bf16_t* dst; int ld; int cbase; int G; int nvalid;
  float* stat; int statbase;
  const float* bias;
};
DI bool seg_swapped(int kind) { return kind != K_VT && kind != K_VCT; }

constexpr int STG = 260;
DI void stage_acc(bf16_t* stg, const f32x16 (&acc)[4][2], int wm, int wn, int r, int h) {
#pragma unroll
  for (int i = 0; i < 4; ++i)
#pragma unroll
    for (int j = 0; j < 2; ++j)
#pragma unroll
      for (int q4 = 0; q4 < 4; ++q4) {
        uint2 pk;
        pk.x = pack2(acc[i][j][4 * q4], acc[i][j][4 * q4 + 1]);
        pk.y = pack2(acc[i][j][4 * q4 + 2], acc[i][j][4 * q4 + 3]);
        *(uint2*)(stg + (wn * 64 + j * 32 + r) * STG + wm * 128 + i * 32 + 8 * q4 + 4 * h) = pk;
      }
}
DI u32x4 stage_read16(const bf16_t* stg, int rr, int c) {
  const uint2 lo = *(const uint2*)(stg + rr * STG + c * 8);
  const uint2 hi = *(const uint2*)(stg + rr * STG + c * 8 + 4);
  u32x4 v; v.x = lo.x; v.y = lo.y; v.z = hi.x; v.w = hi.y; return v;
}
DI void stage_write16(bf16_t* stg, int rr, int c, u32x4 v) {
  *(uint2*)(stg + rr * STG + c * 8) = make_uint2(v.x, v.y);
  *(uint2*)(stg + rr * STG + c * 8 + 4) = make_uint2(v.z, v.w);
}
template <bool NT>
DI void stage_load_tile(bf16_t* stg, const bf16_t* tilebase) {
  const int tid = otid();
  const int r0 = tid >> 5, c = tid & 31;
  const unsigned o0 = (unsigned)(r0 * 1024 + c * 8);
  __builtin_amdgcn_sched_barrier(0);
#pragma unroll
  for (int hf = 0; hf < 2; ++hf) {
#pragma unroll
    for (int it = 8 * hf; it < 8 * hf + 8; ++it) {
      const u32x4* gp = (const u32x4*)(tilebase + (o0 + (unsigned)(it * 16 * 1024)));
      stage_write16(stg, r0 + 16 * it, c, NT ? __builtin_nontemporal_load(gp) : *gp);
    }
    __builtin_amdgcn_sched_barrier(0);
  }
}
DI void stage_store_tile(const bf16_t* stg, bf16_t* tilebase) {
  const int tid = otid();
  const int r0 = tid >> 5, c = tid & 31;
  const unsigned o0 = (unsigned)(r0 * 1024 + c * 8);
#pragma unroll
  for (int it = 0; it < 16; ++it) stg16_nt(tilebase + (o0 + (unsigned)(it * 16 * 1024)), stage_read16(stg, r0 + 16 * it, c));
}

DI void epi_seg(const f32x16 (&acc)[4][2], const Seg& sg0, const Seg& sg1, int m0, int n0, const float* rs, const float2* cs64, const float2* cs32, bf16_t* stg) {
  const int tid = otid();
  const int lane = tid & 63, w = tid >> 6, r = lane & 31, h = lane >> 5;
  const int wm = w >> 2, wn = w & 3;
  const int kind0 = sg0.kind;
  if (kind0 == K_VCT) {
    if (wn == 0) {
#pragma unroll
      for (int i = 0; i < 4; ++i)
#pragma unroll
        for (int q = 0; q < 16; ++q) {
          const int row = m0 + wm * 128 + i * 32 + crow(q, h);
          const int b = row >> 9, n = (row >> 2) & 127, g = row & 3;
#pragma unroll
          for (int j = 0; j < 2; ++j) sg0.dst[((size_t)((b * 4 + g) * 64 + j * 32 + r)) * 128 + n] = f2bf(acc[i][j][q]);
        }
    }
    __syncthreads();
    return;
  }
  if (kind0 == K_VT) {
#pragma unroll
    for (int i = 0; i < 4; ++i)
#pragma unroll
      for (int q4 = 0; q4 < 4; ++q4) {
        const int t0l = wm * 128 + i * 32 + 8 * q4 + 4 * h;
        float s0 = 1.f, s1 = 1.f, s2 = 1.f, s3 = 1.f;
        if (rs) { s0 = rs[t0l]; s1 = rs[t0l + 1]; s2 = rs[t0l + 2]; s3 = rs[t0l + 3]; }
#pragma unroll
        for (int j = 0; j < 2; ++j)
          *(uint2*)(stg + (wn * 64 + j * 32 + r) * STG + t0l) =
              make_uint2(pack2(acc[i][j][4 * q4] * s0, acc[i][j][4 * q4 + 1] * s1), pack2(acc[i][j][4 * q4 + 2] * s2, acc[i][j][4 * q4 + 3] * s3));
      }
    __syncthreads();
    const int b = m0 >> 11, s0 = m0 & (SEQ - 1);
#pragma unroll
    for (int it = 0; it < 16; ++it) {
      const int idx = tid + NTHR * it, rr = idx >> 5, c = idx & 31;
      const int lc = n0 + rr - sg0.cbase, g = lc >> 6, d = lc & 63;
      stg16_nt(sg0.dst + ((size_t)((b * sg0.G + g) * 64 + d)) * SEQ + s0 + c * 8, stage_read16(stg, rr, c));
    }
    __syncthreads();
    return;
  }
  const Seg& sg = wm ? sg1 : sg0;
  const int kind = sg.kind;
  const int lcw = n0 + wm * 128 - sg.cbase;
  const bool wvalid = (kind != K_NONE) && (lcw < sg.nvalid);
  if (wvalid) {
#pragma unroll
    for (int j = 0; j < 2; ++j) {
      const int lrow = wn * 64 + j * 32 + r;
      const float sc = rs ? rs[lrow] : 1.f;
      bf16_t* srow = stg + lrow * STG + wm * 128 + 4 * h;
      if (kind == K_ROPE64 || kind == K_KC2) {
        const int row = m0 + lrow;
        size_t tok = row;
        if (kind == K_KC2) { const int b = row >> 9, n = (row >> 2) & 127; int t = n * 16 + 31; if (t > SEQ - 1) t = SEQ - 1; tok = (size_t)b * SEQ + t; }
        const f32x4* cp = (const f32x4*)(cs64 + tok * 32);
#pragma unroll
        for (int q4 = 0; q4 < 4; ++q4) {
          const f32x4 c01 = cp[(8 * q4 + 4 * h) / 2], c23 = cp[(8 * q4 + 4 * h) / 2 + 1];
          const float cc[4] = {c01.x, c01.z, c23.x, c23.z}, sn[4] = {c01.y, c01.w, c23.y, c23.w};
#pragma unroll
          for (int hd = 0; hd < 2; ++hd) {
            float o1[4], o2[4];
#pragma unroll
            for (int e = 0; e < 4; ++e) {
              const float x1 = acc[2 * hd][j][4 * q4 + e], x2 = acc[2 * hd + 1][j][4 * q4 + e];
              o1[e] = x1 * cc[e] - x2 * sn[e]; o2[e] = x2 * cc[e] + x1 * sn[e];
            }
            *(uint2*)(srow + (2 * hd) * 32 + 8 * q4) = make_uint2(pack2(o1[0], o1[1]), pack2(o1[2], o1[3]));
            *(uint2*)(srow + (2 * hd + 1) * 32 + 8 * q4) = make_uint2(pack2(o2[0], o2[1]), pack2(o2[2], o2[3]));
          }
        }
      } else if (kind == K_ROPE32) {
        const size_t tok = (size_t)(m0 + lrow);
        const f32x4* cp = (const f32x4*)(cs32 + tok * 16);
#pragma unroll
        for (int q4 = 0; q4 < 2; ++q4) {
          const f32x4 c01 = cp[(8 * q4 + 4 * h) / 2], c23 = cp[(8 * q4 + 4 * h) / 2 + 1];
          const float cc[4] = {c01.x, c01.z, c23.x, c23.z}, sn[4] = {c01.y, c01.w, c23.y, c23.w};
#pragma unroll
          for (int i = 0; i < 4; ++i) {
            float o1[4], o2[4];
#pragma unroll
            for (int e = 0; e < 4; ++e) {
              const float x1 = acc[i][j][4 * q4 + e] * sc, x2 = acc[i][j][4 * q4 + e + 8] * sc;
              o1[e] = x1 * cc[e] - x2 * sn[e]; o2[e] = x2 * cc[e] + x1 * sn[e];
            }
            *(uint2*)(srow + i * 32 + 8 * q4) = make_uint2(pack2(o1[0], o1[1]), pack2(o1[2], o1[3]));
            *(uint2*)(srow + i * 32 + 8 * (q4 + 2)) = make_uint2(pack2(o2[0], o2[1]), pack2(o2[2], o2[3]));
          }
        }
      } else {
#pragma unroll
        for (int ch = 0; ch < 2; ++ch) {
          float ss = 0.f;
#pragma unroll
          for (int i = 2 * ch; i < 2 * ch + 2; ++i)
#pragma unroll
            for (int q4 = 0; q4 < 4; ++q4) {
              float v[4] = {acc[i][j][4 * q4] * sc, acc[i][j][4 * q4 + 1] * sc, acc[i][j][4 * q4 + 2] * sc, acc[i][j][4 * q4 + 3] * sc};
              if (kind == K_SILU) {
                const f32x4 bv = *(const f32x4*)(sg.bias + lcw + i * 32 + 8 * q4 + 4 * h);
                v[0] = siluf_(v[0] + bv.x); v[1] = siluf_(v[1] + bv.y); v[2] = siluf_(v[2] + bv.z); v[3] = siluf_(v[3] + bv.w);
              }
              const uint2 pk = make_uint2(pack2(v[0], v[1]), pack2(v[2], v[3]));
              *(uint2*)(srow + i * 32 + 8 * q4) = pk;
              const float f0 = bflo(pk.x), f1 = bfhi(pk.x), f2 = bflo(pk.y), f3 = bfhi(pk.y);
              ss += (f0 * f0 + f1 * f1) + (f2 * f2 + f3 * f3);
            }
          if (sg.stat) {
            ss += shx(ss, 32);
            if (h == 0 && lcw + ch * 64 < sg.nvalid) sg.stat[(size_t)(m0 + lrow) * 16 + sg.statbase + (lcw >> 6) + ch] = ss;
          }
        }
      }
    }
  }
  __syncthreads();
#pragma unroll
  for (int it = 0; it < 16; ++it) {
    const int idx = tid + NTHR * it, rr = idx >> 5, c = idx & 31;
    const Seg& fs = (c >> 4) ? sg1 : sg0;
    const int lcc = n0 + c * 8 - fs.cbase;
    if (fs.kind != K_NONE && lcc < fs.nvalid) {
      const int row = m0 + rr;
      size_t off;
      if (fs.kind == K_KC2) { const int b = row >> 9, n = (row >> 2) & 127, g = row & 3; off = ((size_t)((b * 4 + g) * 128 + n)) * 64 + lcc; }
      else off = (size_t)row * fs.ld + lcc;
      stg16_nt(fs.dst + off, stage_read16(stg, rr, c));
    }
  }
  __syncthreads();
}

DI int kperm(int r) { return (r & 0x13) | ((r & 8) >> 1) | ((r & 4) << 1); }

template <int DQK, bool MASKED, int MODE, class MF>
DI void attn_step(const bf16_t* sK, const bf16_t* sVt, const bf16x8 (&qf)[DQK / 16], f32x16& o0, f32x16& o1, float& m, float& l,
                  float sc, const MF& mf, int lane, f32x16 (&s)[2], float invl, bool lanevalid = true) {
  const int r = lane & 31, h = lane >> 5;
  const int pr = kperm(r);
  constexpr int KST = DQK + 8;
  bf16x8 kf[2][DQK / 16];
#pragma unroll
  for (int sub = 0; sub < 2; ++sub)
#pragma unroll
    for (int ks = 0; ks < DQK / 16; ++ks) kf[sub][ks] = *(const bf16x8*)(sK + (sub * 32 + pr) * KST + ks * 16 + 8 * h);
  __builtin_amdgcn_sched_barrier(0);
#pragma unroll
  for (int q = 0; q < 16; ++q) { s[0][q] = 0.f; s[1][q] = 0.f; }
#pragma unroll
  for (int ks = 0; ks < DQK / 16; ++ks) {
    s[0] = MFMA(kf[0][ks], qf[ks], s[0]);
    s[1] = MFMA(kf[1][ks], qf[ks], s[1]);
  }
  bf16x8 vf[2][2][2];
  if (MODE != 1) {
#pragma unroll
    for (int sub = 0; sub < 2; ++sub)
#pragma unroll
      for (int s2 = 0; s2 < 2; ++s2) {
        vf[sub][s2][0] = *(const bf16x8*)(sVt + r * 72 + sub * 32 + s2 * 16 + 8 * h);
        vf[sub][s2][1] = *(const bf16x8*)(sVt + (32 + r) * 72 + sub * 32 + s2 * 16 + 8 * h);
      }
    __builtin_amdgcn_sched_barrier(0);
  }
  float mxr = -3.0e38f;
#pragma unroll
  for (int sub = 0; sub < 2; ++sub)
#pragma unroll
    for (int q = 0; q < 16; ++q) {
      if (MASKED) { const int kk = sub * 32 + 16 * (q >> 3) + 8 * h + (q & 7); s[sub][q] = mf(kk) ? s[sub][q] : -3.0e38f; }
      if (MODE != 2) mxr = fmaxf(mxr, s[sub][q]);
    }
  float alpha = 1.f;
  if (MODE != 2) {
    float mx = fmaxf(m, mxr * sc);
    mx = fmaxf(mx, shx(mx, 32));
    if (!MASKED) mx = lanevalid ? mx : m;
    alpha = fexp2(m - mx);
    m = mx;
  }
  const float moff = (!MASKED && !lanevalid) ? 1.0e30f : m;
  float ps = 0.f;
#pragma unroll
  for (int sub = 0; sub < 2; ++sub)
#pragma unroll
    for (int q = 0; q < 16; ++q) {
      float pv = fexp2(__builtin_fmaf(s[sub][q], sc, -moff));
      if (MASKED && MODE != 0) pv = (s[sub][q] > -1.0e38f) ? pv : 0.f;
      if (MODE == 2) pv *= invl;
      s[sub][q] = pv;
      ps += pv;
    }
  if (MODE != 2) {
    ps += shx(ps, 32);
    l = l * alpha + ps;
  }
  if (MODE == 1) return;
  if (MODE == 0) {
#pragma unroll
    for (int q = 0; q < 16; ++q) { o0[q] *= alpha; o1[q] *= alpha; }
  }
#pragma unroll
  for (int sub = 0; sub < 2; ++sub)
#pragma unroll
    for (int s2 = 0; s2 < 2; ++s2) {
      union { bf16x8 v; unsigned u[4]; } pb;
#pragma unroll
      for (int e = 0; e < 4; ++e) pb.u[e] = pack2(s[sub][8 * s2 + 2 * e], s[sub][8 * s2 + 2 * e + 1]);
      o0 = MFMA(vf[sub][s2][0], pb.v, o0);
      o1 = MFMA(vf[sub][s2][1], pb.v, o1);
    }
}

constexpr int KVB64 = 2 * 64 * 72;
constexpr int KVB96 = 64 * 104 + 64 * 72;
struct KVR { u32x4 k0, k1, k2, v0, v1; };
DI void kv64_fetch(KVR& R, const bf16_t* kbase, int kstride, const bf16_t* vtbase, int vtstride, int key0, bool withV, int tid) {
  const int row0 = tid >> 3, kc = tid & 7, row1 = row0 + 32;
  R.k0 = ldg16(kbase + (size_t)(key0 + row0) * kstride + kc * 8);
  R.k1 = ldg16(kbase + (size_t)(key0 + row1) * kstride + kc * 8);
  if (withV) { R.v0 = ldg16(vtbase + (size_t)row0 * vtstride + key0 + kc * 8); R.v1 = ldg16(vtbase + (size_t)row1 * vtstride + key0 + kc * 8); }
}
DI void kv64_commit(const KVR& R, bf16_t* sK, bf16_t* sVt, bool withV, int tid) {
  const int row0 = tid >> 3, kc = tid & 7, row1 = row0 + 32;
  __syncthreads();
  *(u32x4*)(sK + row0 * 72 + kc * 8) = R.k0;
  *(u32x4*)(sK + row1 * 72 + kc * 8) = R.k1;
  if (withV) { *(u32x4*)(sVt + row0 * 72 + kc * 8) = R.v0; *(u32x4*)(sVt + row1 * 72 + kc * 8) = R.v1; }
  __syncthreads();
}
DI void kv64_store(const KVR& R, bf16_t* sK, bf16_t* sVt, int tid) {
  const int row0 = tid >> 3, kc = tid & 7, row1 = row0 + 32;
  *(u32x4*)(sK + row0 * 72 + kc * 8) = R.k0;
  *(u32x4*)(sK + row1 * 72 + kc * 8) = R.k1;
  *(u32x4*)(sVt + row0 * 72 + kc * 8) = R.v0;
  *(u32x4*)(sVt + row1 * 72 + kc * 8) = R.v1;
}
DI void kv96_store(const KVR& R, bf16_t* sK, bf16_t* sVt, int tid) {
  const int row0 = tid >> 3, kc = tid & 7, row1 = row0 + 32;
  const int rr = tid >> 2, rc = tid & 3;
  *(u32x4*)(sK + row0 * 104 + kc * 8) = R.k0;
  *(u32x4*)(sK + row1 * 104 + kc * 8) = R.k1;
  *(u32x4*)(sK + rr * 104 + 64 + rc * 8) = R.k2;
  *(u32x4*)(sVt + row0 * 72 + kc * 8) = R.v0;
  *(u32x4*)(sVt + row1 * 72 + kc * 8) = R.v1;
}
DI void kv96_fetch(KVR& R, const bf16_t* knbase  , const bf16_t* krbase, const bf16_t* vtbase, int key0, int tid) {
  const int row0 = tid >> 3, kc = tid & 7, row1 = row0 + 32;
  const int rr = tid >> 2, rc = tid & 3;
  R.k0 = ldg16(knbase + (size_t)(key0 + row0) * 1024 + kc * 8);
  R.k1 = ldg16(knbase + (size_t)(key0 + row1) * 1024 + kc * 8);
  R.k2 = ldg16(krbase + (size_t)(key0 + rr) * 32 + rc * 8);
  R.v0 = ldg16(vtbase + (size_t)row0 * SEQ + key0 + kc * 8);
  R.v1 = ldg16(vtbase + (size_t)row1 * SEQ + key0 + kc * 8);
}
DI void kv96_commit(const KVR& R, bf16_t* sK, bf16_t* sVt, int tid) {
  const int row0 = tid >> 3, kc = tid & 7, row1 = row0 + 32;
  const int rr = tid >> 2, rc = tid & 3;
  __syncthreads();
  *(u32x4*)(sK + row0 * 104 + kc * 8) = R.k0;
  *(u32x4*)(sK + row1 * 104 + kc * 8) = R.k1;
  *(u32x4*)(sK + rr * 104 + 64 + rc * 8) = R.k2;
  *(u32x4*)(sVt + row0 * 72 + kc * 8) = R.v0;
  *(u32x4*)(sVt + row1 * 72 + kc * 8) = R.v1;
  __syncthreads();
}

DI void o_zero(f32x16& a, f32x16& b) {
#pragma unroll
  for (int q = 0; q < 16; ++q) { a[q] = 0.f; b[q] = 0.f; }
}

DI int logical_bid() {
  const int G = gridDim.x, bx = blockIdx.x;
  return (G % 8 == 0) ? (bx % 8) * (G / 8) + bx / 8 : bx;
}

DI int colmap(int kind, int n) {
  switch (kind) {
    case 0: return n;
    case 1: return n < 640 ? n : (n < 1664 ? n + 32 : (n < 1696 ? n - 1024 : -1));
    case 2: if (n < 1024) return (n >> 6) * 96 + (n & 63); else { int m = n - 1024; return (m >> 5) * 96 + 64 + (m & 31); }
    case 3: if (n < 1024) return (n >> 6) * 128 + (n & 63); else { int m = n - 1024; return (m >> 6) * 128 + 64 + (m & 63); }
    case 4: return n < 2560 ? n : (n < 3584 ? n + 48 : (n < 3632 ? n - 1024 : -1));
    default: return n < 64 ? n : -1;
  }
}

DI void prep_transpose(const float* W, int K, int Nsrc, int Nd, int kind, const float* kscale, bf16_t* dst, float* tileL, int L, int G) {
  const int tid = otid();
  const int ktiles = K / 64, ntiles = Nd / 64;
  for (int t = L; t < ktiles * ntiles; t += G) {
    const int nt = t / ktiles, kt = t - nt * ktiles;
    const int k0 = kt * 64, n0 = nt * 64;
    const int tx = tid & 63, ty = tid >> 6;
    const int src = colmap(kind, n0 + tx);
    __syncthreads();
    for (int kk = ty; kk < 64; kk += 8) {
      float v = 0.f;
      if (src >= 0) { v = W[(size_t)(k0 + kk) * Nsrc + src]; if (kscale) v *= kscale[k0 + kk]; }
      tileL[kk * 65 + tx] = v;
    }
    __syncthreads();
    const int nl = tid >> 3, kq = tid & 7;
    unsigned pk[4];
#pragma unroll
    for (int e = 0; e < 4; ++e) pk[e] = pack2(tileL[(kq * 8 + 2 * e) * 65 + nl], tileL[(kq * 8 + 2 * e + 1) * 65 + nl]);
    *(uint4*)(dst + (size_t)(n0 + nl) * K + k0 + kq * 8) = make_uint4(pk[0], pk[1], pk[2], pk[3]);
  }
}

DI void phase_prep(const Params& P, unsigned char* smem, int L, int G) {
  unsigned char* ws = P.ws;
  float* tileL = (float*)smem;
  const int tid = otid();
  prep_transpose(P.l0_w_in, 1024, 2560, 2560, 0, nullptr, (bf16_t*)(ws + OFF_WIN0T), tileL, L, G);
  prep_transpose(P.l1_w_in, 1024, 1696, 1792, 1, nullptr, (bf16_t*)(ws + OFF_WIN1T), tileL, L, G);
  prep_transpose(P.l2_w_in, 1024, 3632, 3840, 4, nullptr, (bf16_t*)(ws + OFF_WIN2T), tileL, L, G);
  prep_transpose(P.l3_w_in, 1024, 2560, 2560, 0, nullptr, (bf16_t*)(ws + OFF_WIN3T), tileL, L, G);
  prep_transpose(P.l1_w_uq, 384, 1536, 1536, 2, P.l1_q_norm, (bf16_t*)(ws + OFF_WUQT), tileL, L, G);
  prep_transpose(P.l1_w_ukv, 256, 2048, 2048, 3, P.l1_kv_norm, (bf16_t*)(ws + OFF_WUKVT), tileL, L, G);
  prep_transpose(P.l2_phi_k1, 2048, 256, 256, 0, nullptr, (bf16_t*)(ws + OFF_PK1T), tileL, L, G);
  prep_transpose(P.l2_phi_v1, 2048, 256, 256, 0, nullptr, (bf16_t*)(ws + OFF_PV1T), tileL, L, G);
  prep_transpose(P.l2_phi_k2, 256, 64, 256, 5, nullptr, (bf16_t*)(ws + OFF_PK2T), tileL, L, G);
  prep_transpose(P.l2_phi_v2, 256, 64, 256, 5, nullptr, (bf16_t*)(ws + OFF_PV2T), tileL, L, G);
  for (int i = 0; i < 4; ++i) {
    prep_transpose(P.w_out + (size_t)i * 1024 * 1024, 1024, 1024, 1024, 0, nullptr, (bf16_t*)(ws + OFF_WOUTT) + (size_t)i * 1024 * 1024, tileL, L, G);
    prep_transpose(P.pe_gate + (size_t)i * 1024 * 1024, 1024, 1024, 1024, 0, P.ln_g + i * 1024, (bf16_t*)(ws + OFF_PGT) + (size_t)i * 1024 * 1024, tileL, L, G);
    prep_transpose(P.pe_proj + (size_t)i * 256 * 1024, 256, 1024, 1024, 0, nullptr, (bf16_t*)(ws + OFF_PPT) + (size_t)i * 1024 * 256, tileL, L, G);
  }
  __syncthreads();
  {
    float* red = (float*)smem;
    float* c1 = (float*)(ws + OFF_C1); float* c2 = (float*)(ws + OFF_C2);
    for (int t = L; t < 128; t += G) {
      const int i = t >> 5, n0 = (t & 31) * 32;
      const int kp = tid >> 5, nn = tid & 31;
      const float* W = P.pe_gate + (size_t)i * 1024 * 1024;
      const float* g = P.ln_g + i * 1024; const float* bb = P.ln_b + i * 1024;
      float s1 = 0.f, s2 = 0.f;
      for (int k = kp * 64; k < kp * 64 + 64; ++k) {
        const float wv = W[(size_t)k * 1024 + n0 + nn];
        s1 += bf2f(f2bf(g[k] * wv)); s2 += bb[k] * wv;
      }
      __syncthreads();
      red[kp * 32 + nn] = s1; red[512 + kp * 32 + nn] = s2;
      __syncthreads();
      if (tid < 32) {
        float a = 0.f, b2 = 0.f;
        for (int q = 0; q < 16; ++q) { a += red[q * 32 + tid]; b2 += red[512 + q * 32 + tid]; }
        c1[i * 1024 + n0 + tid] = a; c2[i * 1024 + n0 + tid] = b2;
      }
    }
    __syncthreads();
    float* bias = (float*)(ws + OFF_BIAS);
    for (int t = L; t < 16; t += G) {
      const int which = t >> 3, n0 = (t & 7) * 32;
      const int kp = tid >> 5, nn = tid & 31;
      const float* W = which ? P.l2_phi_v1 : P.l2_phi_k1;
      float s1 = 0.f;
      for (int k = kp * 128; k < kp * 128 + 128; ++k) s1 += P.l2_cmp_pos[k] * W[(size_t)k * 256 + n0 + nn];
      __syncthreads();
      red[kp * 32 + nn] = s1;
      __syncthreads();
      if (tid < 32) { float a = 0.f; for (int q = 0; q < 16; ++q) a += red[q * 32 + tid]; bias[which * 256 + n0 + tid] = a; }
    }
  }
  {
    bf16_t* xbw = (bf16_t*)(ws + OFF_XB); bf16_t* pbw = (bf16_t*)(ws + OFF_PB);
    const size_t nx8 = (size_t)MTOK * 1024 / 8, np8 = (size_t)4 * MTOK * 256 / 8;
    for (size_t idx = (size_t)L * NTHR + tid; idx < nx8 + np8; idx += (size_t)G * NTHR) {
      const bool isx = idx < nx8;
      const size_t e = (isx ? idx : idx - nx8) * 8;
      const float* src = (isx ? P.x : P.p) + e;
      const f32x4 f0 = ldgf4(src), f1 = ldgf4(src + 4);
      *(u32x4*)((isx ? xbw : pbw) + e) = cvt8(f0, f1);
    }
  }
  {
    float2* cs64 = (float2*)(ws + OFF_CS64); float2* cs32 = (float2*)(ws + OFF_CS32);
    const size_t total = (size_t)MTOK * 48;
    for (size_t idx = (size_t)L * NTHR + tid; idx < total; idx += (size_t)G * NTHR) {
      const int tok = (int)(idx / 48), e = (int)(idx - (size_t)tok * 48);
      const float posf = (float)P.pos[tok];
      float sn, cn;
      if (e < 32) { const float inv = powf(10000.f, -(float)e / 32.f); sincosf(posf * inv, &sn, &cn); cs64[(size_t)tok * 32 + e] = make_float2(cn, sn); }
      else { const int e2 = e - 32; const float inv = powf(10000.f, -(float)e2 / 16.f); sincosf(posf * inv, &sn, &cn); cs32[(size_t)tok * 16 + e2] = make_float2(cn, sn); }
    }
  }
}

DI Seg seg_for(int mixer, int nt, bf16_t* big, float* mstat) {
  Seg s; s.kind = K_PLAIN; s.dst = big; s.ld = 1024; s.cbase = 0; s.G = 4; s.nvalid = 1 << 30; s.stat = nullptr; s.statbase = 0; s.bias = nullptr;
  if (mixer == 0) {
    if (nt < 8) { s.kind = K_ROPE64; s.dst = big + SW_Q; s.ld = 1024; s.cbase = 0; }
    else if (nt < 10) { s.kind = K_ROPE64; s.dst = big + SW_K; s.ld = 256; s.cbase = 1024; }
    else if (nt < 12) { s.kind = K_VT; s.dst = big + SW_VT; s.cbase = 1280; s.G = 4; }
    else { s.kind = K_PLAIN; s.dst = big + SW_Z; s.ld = 1024; s.cbase = 1536; }
  } else if (mixer == 1) {
    if (nt < 3) { s.dst = big + ML_CQ; s.ld = 384; s.cbase = 0; s.stat = mstat; s.statbase = 0; }
    else if (nt < 5) { s.dst = big + ML_CKV; s.ld = 256; s.cbase = 384; s.stat = mstat; s.statbase = 6; }
    else if (nt < 13) { s.dst = big + ML_Z; s.ld = 1024; s.cbase = 640; }
    else { s.kind = K_ROPE32; s.dst = big + ML_KR; s.ld = 32; s.cbase = 1664; s.nvalid = 32; }
  } else if (mixer == 2) {
    if (nt < 8) { s.kind = K_ROPE64; s.dst = big + NS_Q; s.ld = 1024; s.cbase = 0; }
    else if (nt < 10) { s.dst = big + NS_KCR; s.ld = 256; s.cbase = 1024; }
    else if (nt < 12) { s.dst = big + NS_VCR; s.ld = 256; s.cbase = 1280; }
    else if (nt < 14) { s.kind = K_ROPE64; s.dst = big + NS_KS; s.ld = 256; s.cbase = 1536; }
    else if (nt < 16) { s.kind = K_VT; s.dst = big + NS_VST; s.cbase = 1792; }
    else if (nt < 18) { s.kind = K_ROPE64; s.dst = big + NS_KW; s.ld = 256; s.cbase = 2048; }
    else if (nt < 20) { s.kind = K_VT; s.dst = big + NS_VWT; s.cbase = 2304; }
    else if (nt < 28) { s.dst = big + NS_Z; s.ld = 1024; s.cbase = 2560; }
    else if (nt == 28) { s.dst = big + NS_GL; s.ld = 64; s.cbase = 3584; s.nvalid = 64; }
    else s.kind = K_NONE;
  } else if (mixer == 3) {
    if (nt < 8) { s.dst = big + ML_QN; s.ld = 1024; s.cbase = 0; }
    else { s.kind = K_ROPE32; s.dst = big + ML_QR; s.ld = 512; s.cbase = 1024; }
  } else if (mixer == 4) {
    if (nt < 8) { s.dst = big + ML_KN; s.ld = 1024; s.cbase = 0; }
    else { s.kind = K_VT; s.dst = big + ML_VT; s.cbase = 1024; s.G = 16; }
  } else if (mixer == 5) {
    s.dst = big + BG_PP; s.ld = 1024; s.cbase = 0;
  }
  return s;
}

DI void panel_tile(int t, int ntn, int pw, int& mt, int& nt) {
  const int per_panel = 256 * pw;
  const int p = t / per_panel;
  const int n0 = p * pw;
  const int w = (ntn - n0) < pw ? (ntn - n0) : pw;
  const int tt = t - p * per_panel;
  mt = tt / w; nt = n0 + (tt - mt * w);
}

template <bool AF32>
DI void phase_inproj_impl(const void* A, int lda, int nk, const bf16_t* Bt, int ntn, int mixer, const Params& P, unsigned char* smem, int L, int G) {
  bf16_t* big = (bf16_t*)(P.ws + OFF_BIG);
  float* mstat = (float*)(P.ws + OFF_MSTAT);
  const float2* cs64 = (const float2*)(P.ws + OFF_CS64);
  const float2* cs32 = (const float2*)(P.ws + OFF_CS32);
  const int ntiles = 256 * ntn;
  const int ldb = nk * 64;
  GR R;
  ARowPlain arb{(const bf16_t*)A, lda};
  const int pw = ntn > 5 ? 5 : ntn;
  if (L < ntiles) { int mt, nt; panel_tile(L, ntn, pw, mt, nt); gemm_first<false>(R, arb, Bt, ldb, mt * 256, nt * 256); }
  for (int t = L; t < ntiles; t += G) {
    int mt, nt; panel_tile(t, ntn, pw, mt, nt);
    f32x16 acc[4][2]; acc_zero(acc);
    const Seg sg0 = seg_for(mixer, nt * 2, big, mstat), sg1 = seg_for(mixer, nt * 2 + 1, big, mstat);
    const bool swp = seg_swapped(sg0.kind);
    gemm_loop<false>(acc, R, arb, Bt, ldb, mt * 256, nt * 256, nk, (bf16_t*)smem, swp);
    if (t + G < ntiles) { int mt2, nt2; panel_tile(t + G, ntn, pw, mt2, nt2); gemm_first<false>(R, arb, Bt, ldb, mt2 * 256, nt2 * 256); }
    __builtin_amdgcn_sched_barrier(0);
    epi_seg(acc, sg0, sg1, mt * 256, nt * 256, nullptr, cs64, cs32, (bf16_t*)smem);
  }
}

DI void phase_mla_up(const Params& P, unsigned char* smem, int L, int G) {
  bf16_t* big = (bf16_t*)(P.ws + OFF_BIG);
  const float* mstat = (const float*)(P.ws + OFF_MSTAT);
  const float2* cs64 = (const float2*)(P.ws + OFF_CS64);
  const float2* cs32 = (const float2*)(P.ws + OFF_CS32);
  float* rowA = (float*)(smem + LDS_ROW_OFF);
  const int nq = 256 * 6, nkv = 256 * 8;
  for (int t = L; t < nq + nkv; t += G) {
    const int tid = otid();
    const bool isq = t < nq;
    const int tt = isq ? t : t - nq;
    const int ntn = isq ? 6 : 8;
    const int mt = tt / ntn, nt = tt - mt * ntn;
    if (tid < 256) {
      const float* ms = mstat + (size_t)(mt * 256 + tid) * 16;
      float ssum;
      if (isq) ssum = (ms[0] + ms[1] + ms[2] + ms[3] + ms[4] + ms[5]) * (1.f / 384.f);
      else ssum = (ms[6] + ms[7] + ms[8] + ms[9]) * (1.f / 256.f);
      rowA[tid] = rsqrtf(ssum + 1e-6f);
    }
    f32x16 acc[4][2]; acc_zero(acc);
    const Seg sg0 = seg_for(isq ? 3 : 4, nt * 2, big, nullptr), sg1 = seg_for(isq ? 3 : 4, nt * 2 + 1, big, nullptr);
    const bool swp = seg_swapped(sg0.kind);
    GR R;
    if (isq) { ARowPlain ar{big + ML_CQ, 384}; gemm_first<false>(R, ar, (const bf16_t*)(P.ws + OFF_WUQT), 384, mt * 256, nt * 256); gemm_loop<false>(acc, R, ar, (const bf16_t*)(P.ws + OFF_WUQT), 384, mt * 256, nt * 256, 6, (bf16_t*)smem, swp); }
    else { ARowPlain ar{big + ML_CKV, 256}; gemm_first<false>(R, ar, (const bf16_t*)(P.ws + OFF_WUKVT), 256, mt * 256, nt * 256); gemm_loop<false>(acc, R, ar, (const bf16_t*)(P.ws + OFF_WUKVT), 256, mt * 256, nt * 256, 4, (bf16_t*)smem, swp); }
    epi_seg(acc, sg0, sg1, mt * 256, nt * 256, rowA, cs64, cs32, (bf16_t*)smem);
  }
}

DI void phase_cmp1(const Params& P, unsigned char* smem, int L, int G) {
  bf16_t* big = (bf16_t*)(P.ws + OFF_BIG);
  const float* bias = (const float*)(P.ws + OFF_BIAS);
  for (int t = L; t < 128; t += G) {
    const int which = t >> 6, mt = t & 63;
    f32x16 acc[4][2]; acc_zero(acc);
    ARowCmp ar{big + (which ? NS_VCR : NS_KCR)};
    GR R; gemm_first<false>(R, ar, (const bf16_t*)(P.ws + (which ? OFF_PV1T : OFF_PK1T)), 2048, mt * 256, 0);
    gemm_loop<false>(acc, R, ar, (const bf16_t*)(P.ws + (which ? OFF_PV1T : OFF_PK1T)), 2048, mt * 256, 0, 32, (bf16_t*)smem, true);
    Seg s; s.kind = K_SILU; s.dst = big + (which ? NS_HV : NS_HK); s.ld = 256; s.cbase = 0; s.G = 4; s.nvalid = 1 << 30; s.stat = nullptr; s.statbase = 0;
    s.bias = bias + which * 256;
    epi_seg(acc, s, s, mt * 256, 0, nullptr, nullptr, nullptr, (bf16_t*)smem);
  }
}
DI void phase_cmp2(const Params& P, unsigned char* smem, int L, int G) {
  bf16_t* big = (bf16_t*)(P.ws + OFF_BIG);
  const float2* cs64 = (const float2*)(P.ws + OFF_CS64);
  for (int t = L; t < 128; t += G) {
    const int which = t >> 6, mt = t & 63;
    f32x16 acc[4][2]; acc_zero(acc);
    ARowPlain ar{big + (which ? NS_HV : NS_HK), 256};
    GR R; gemm_first<false>(R, ar, (const bf16_t*)(P.ws + (which ? OFF_PV2T : OFF_PK2T)), 256, mt * 256, 0);
    gemm_loop<false>(acc, R, ar, (const bf16_t*)(P.ws + (which ? OFF_PV2T : OFF_PK2T)), 256, mt * 256, 0, 4, (bf16_t*)smem, !which);
    Seg s; s.kind = which ? K_VCT : K_KC2; s.dst = big + (which ? NS_VCT : NS_KC2); s.ld = 64; s.cbase = 0; s.G = 4; s.nvalid = 64; s.stat = nullptr; s.statbase = 0; s.bias = nullptr;
    Seg none = s; none.kind = K_NONE;
    epi_seg(acc, s, none, mt * 256, 0, nullptr, cs64, nullptr, (bf16_t*)smem);
  }
}

DI void attn_write_staged(const f32x16& o0, const f32x16& o1, bf16_t* og, const bf16_t* z, size_t tok0, int head, int lane, bf16_t* wl) {
  const int q = lane & 31, h = lane >> 5;
#pragma unroll
  for (int dt = 0; dt < 2; ++dt)
#pragma unroll
    for (int q4 = 0; q4 < 4; ++q4) {
      const f32x16& o = dt ? o1 : o0;
      *(uint2*)(wl + q * 72 + dt * 32 + 8 * q4 + 4 * h) = make_uint2(pack2(o[4 * q4], o[4 * q4 + 1]), pack2(o[4 * q4 + 2], o[4 * q4 + 3]));
    }
#pragma unroll
  for (int k = 0; k < 4; ++k) {
    const int ci = lane + 64 * k, row = ci >> 3, c8 = ci & 7;
    const u32x4 ov = *(const u32x4*)(wl + row * 72 + c8 * 8);
    const size_t off = (tok0 + row) * 1024 + head * 64 + c8 * 8;
    const u32x4 zv = ldg16(z + off);
    u32x4 r;
    r.x = pack2(bflo(ov.x) * siluf_(bflo(zv.x)), bfhi(ov.x) * siluf_(bfhi(zv.x)));
    r.y = pack2(bflo(ov.y) * siluf_(bflo(zv.y)), bfhi(ov.y) * siluf_(bfhi(zv.y)));
    r.z = pack2(bflo(ov.z) * siluf_(bflo(zv.z)), bfhi(ov.z) * siluf_(bfhi(zv.z)));
    r.w = pack2(bflo(ov.w) * siluf_(bflo(zv.w)), bfhi(ov.w) * siluf_(bfhi(zv.w)));
    *(u32x4*)(og + off) = r;
  }
}
DI void attn_write(const f32x16& o0, const f32x16& o1, bf16_t* og, const bf16_t* z, size_t tok, int head, int h) {
#pragma unroll
  for (int dt = 0; dt < 2; ++dt)
#pragma unroll
    for (int q4 = 0; q4 < 4; ++q4) {
      const int d = dt * 32 + 8 * q4 + 4 * h;
      const size_t off = tok * 1024 + head * 64 + d;
      const uint2 zz = *(const uint2*)(z + off);
      const f32x16& o = dt ? o1 : o0;
      uint2 pk;
      pk.x = pack2(o[4 * q4] * siluf_(bflo(zz.x)), o[4 * q4 + 1] * siluf_(bfhi(zz.x)));
      pk.y = pack2(o[4 * q4 + 2] * siluf_(bflo(zz.y)), o[4 * q4 + 3] * siluf_(bfhi(zz.y)));
      *(uint2*)(og + off) = pk;
    }
}

DI void gqa_item(int p, int L, int G, int gi, int& qt, int& bg) {
  if (G == 256) { const int x = L >> 5, lb = L & 31, k = p >> 8; bg = x * 16 + (k & ~1) + gi; qt = (k & 1) ? 63 - lb : lb; }
  else { qt = 63 - (p >> 6); bg = (p & 63) * 2 + gi; }
}
DI void mla_item(int p, int L, int G, int gi, int& qt, int& bh) {
  if (G == 256) { const int x = L >> 5, lb = L & 31, k = p >> 8; bh = x * 64 + k * 4 + (lb >> 4) * 2 + gi; qt = (k & 1) ? 15 - (lb & 15) : (lb & 15); }
  else { qt = 15 - (p >> 8); bh = (p & 255) * 2 + gi; }
}

DI void phase_attn_swa(const Params& P, const float* sinks, bf16_t* og, unsigned char* smem, int L, int G) {
  bf16_t* big = (bf16_t*)(P.ws + OFF_BIG);
  const int tid0 = otid(), gi = tid0 >> 8, tid = tid0 & 255, lane = tid & 63, w = tid >> 6, r = lane & 31, h = lane >> 5;
  smem += gi * ATT_LDS;
  bf16_t* sK = (bf16_t*)smem; bf16_t* sVt = sK + 64 * 72;
  const float sc = 0.125f * LOG2E;
  for (int it = L; it < 4096; it += G) {
    int qt, bg; gqa_item(it, L, G, gi, qt, bg);
    const int b = bg >> 2, g = bg & 3;
    const int t0 = qt * 32, t = t0 + r, head = g * 4 + w;
    const size_t tok = (size_t)b * SEQ + t;
    bf16x8 qf[4];
#pragma unroll
    for (int ks = 0; ks < 4; ++ks) qf[ks] = *(const bf16x8*)(big + SW_Q + tok * 1024 + head * 64 + ks * 16 + 8 * h);
    f32x16 o0, o1, s[2]; o_zero(o0, o1);
    float m = sinks[head] * LOG2E, l = 1.f;
    const bf16_t* kb = big + SW_K + (size_t)b * SEQ * 256 + g * 64;
    const bf16_t* vb = big + SW_VT + (size_t)((b * 4 + g) * 64) * SEQ;
    const int jlo = (t0 - 127 > 0 ? t0 - 127 : 0) >> 6, jhi = (t0 + 31) >> 6;
    KVR R; kv64_fetch(R, kb, 256, vb, SEQ, jlo * 64, true, tid);
    __syncthreads();
    kv64_store(R, sK, sVt, tid);
    if (jlo < jhi) kv64_fetch(R, kb, 256, vb, SEQ, jlo * 64 + 64, true, tid);
    for (int j = jlo; j <= jhi; ++j) {
      const int key0 = j * 64, cb = (j - jlo) & 1;
      __syncthreads();
      if (j < jhi) kv64_store(R, sK + (cb ^ 1) * KVB64, sVt + (cb ^ 1) * KVB64, tid);
      if (j + 1 < jhi) kv64_fetch(R, kb, 256, vb, SEQ, key0 + 128, true, tid);
      __builtin_amdgcn_sched_barrier(0);
      auto mf = [&](int kk) { const int key = key0 + kk; return key <= t && key > t - 128; };
      attn_step<64, true, 0>(sK + cb * KVB64, sVt + cb * KVB64, qf, o0, o1, m, l, sc, mf, lane, s, 0.f);
    }
    const float il = 1.f / l;
#pragma unroll
    for (int q = 0; q < 16; ++q) { o0[q] *= il; o1[q] *= il; }
    attn_write_staged(o0, o1, og, big + SW_Z, (size_t)b * SEQ + t0, head, lane, (bf16_t*)(smem + 40960) + w * (32 * 72));
  }
}

struct KVR8 { u32x4 k0, k2, v0; };
DI void kv96x8_fetch(KVR8& R, const bf16_t* knbase, const bf16_t* krbase, const bf16_t* vtbase, int key0, int tid) {
  const int row = tid >> 3, kc = tid & 7, rr = (tid & 255) >> 2, rc = tid & 3;
  R.k0 = ldg16(knbase + (size_t)(key0 + row) * 1024 + kc * 8);
  R.k2 = ldg16(krbase + (size_t)(key0 + rr) * 32 + rc * 8);
  R.v0 = ldg16(vtbase + (size_t)row * SEQ + key0 + kc * 8);
}
DI void kv96x8_store(const KVR8& R, bf16_t* sK, bf16_t* sVt, int tid) {
  const int row = tid >> 3, kc = tid & 7, rr = (tid & 255) >> 2, rc = tid & 3;
  *(u32x4*)(sK + row * 104 + kc * 8) = R.k0;
  if (tid < 256) *(u32x4*)(sK + rr * 104 + 64 + rc * 8) = R.k2;
  *(u32x4*)(sVt + row * 72 + kc * 8) = R.v0;
}
DI void mla_item8(int p, int L, int G, int& qt, int& bh) {
  if (G == 256) { const int x = L >> 5, lb = L & 31, k = p >> 8; bh = x * 64 + k * 4 + (lb >> 3); qt = (k & 1) ? 7 - (lb & 7) : (lb & 7); }
  else { qt = 7 - (p >> 9); bh = p & 511; }
}
DI void phase_attn_mla(const Params& P, bf16_t* og, unsigned char* smem, int L, int G) {
  bf16_t* big = (bf16_t*)(P.ws + OFF_BIG);
  const int tid = otid(), lane = tid & 63, w = tid >> 6, r = lane & 31, h = lane >> 5;
  bf16_t* sK = (bf16_t*)smem; bf16_t* sVt = sK + 64 * 104;
  const float sc = 0.10206207261596575f * LOG2E;
  for (int it = L; it < 4096; it += G) {
    int qt, bh; mla_item8(it, L, G, qt, bh);
    const int b = bh >> 4, head = bh & 15;
    const int t0 = qt * 256 + w * 32, t = t0 + r;
    const size_t tok = (size_t)b * SEQ + t;
    bf16x8 qf[6];
#pragma unroll
    for (int ks = 0; ks < 4; ++ks) qf[ks] = *(const bf16x8*)(big + ML_QN + tok * 1024 + head * 64 + ks * 16 + 8 * h);
#pragma unroll
    for (int ks = 0; ks < 2; ++ks) qf[4 + ks] = *(const bf16x8*)(big + ML_QR + tok * 512 + head * 32 + ks * 16 + 8 * h);
    f32x16 o0, o1, s[2]; o_zero(o0, o1);
    float m = NEGF, l = 0.f;
    const bf16_t* knb = big + ML_KN + (size_t)b * SEQ * 1024 + head * 64;
    const bf16_t* krb = big + ML_KR + (size_t)b * SEQ * 32;
    const bf16_t* vb = big + ML_VT + (size_t)((b * 16 + head) * 64) * SEQ;
    const int jhi = (qt * 256 + 255) >> 6;
    KVR8 R; kv96x8_fetch(R, knb, krb, vb, 0, tid);
    __syncthreads();
    kv96x8_store(R, sK, sVt, tid);
    if (0 < jhi) kv96x8_fetch(R, knb, krb, vb, 64, tid);
    for (int j = 0; j <= jhi; ++j) {
      const int key0 = j * 64, cb = j & 1;
      __syncthreads();
      if (j < jhi) kv96x8_store(R, sK + (cb ^ 1) * KVB96, sVt + (cb ^ 1) * KVB96, tid);
      if (j + 1 < jhi) kv96x8_fetch(R, knb, krb, vb, key0 + 128, tid);
      __builtin_amdgcn_sched_barrier(0);
      if (key0 <= t0 + 31) {
        auto mf = [&](int kk) { return key0 + kk <= t; };
        if (key0 + 63 > t0) attn_step<96, true, 0>(sK + cb * KVB96, sVt + cb * KVB96, qf, o0, o1, m, l, sc, mf, lane, s, 0.f);
        else attn_step<96, false, 0>(sK + cb * KVB96, sVt + cb * KVB96, qf, o0, o1, m, l, sc, mf, lane, s, 0.f);
      }
    }
    const float il = 1.f / l;
#pragma unroll
    for (int q = 0; q < 16; ++q) { o0[q] *= il; o1[q] *= il; }
    attn_write_staged(o0, o1, og, big + ML_Z, (size_t)b * SEQ + t0, head, lane, (bf16_t*)(smem + 49152) + w * (32 * 72));
  }
}

DI void tot_store(float* totL, int tid, const f32x16& a, const f32x16& b, float gi) {
#pragma unroll
  for (int k = 0; k < 4; ++k) {
    f32x4 v0 = {a[4 * k] * gi, a[4 * k + 1] * gi, a[4 * k + 2] * gi, a[4 * k + 3] * gi};
    f32x4 v1 = {b[4 * k] * gi, b[4 * k + 1] * gi, b[4 * k + 2] * gi, b[4 * k + 3] * gi};
    *(f32x4*)(totL + ((size_t)(k * 256 + tid)) * 4) = v0;
    *(f32x4*)(totL + ((size_t)((4 + k) * 256 + tid)) * 4) = v1;
  }
}
DI void tot_addto(float* totL, int tid, f32x16& a, f32x16& b, float gi) {
#pragma unroll
  for (int k = 0; k < 4; ++k) {
    const f32x4 v0 = *(const f32x4*)(totL + ((size_t)(k * 256 + tid)) * 4);
    const f32x4 v1 = *(const f32x4*)(totL + ((size_t)((4 + k) * 256 + tid)) * 4);
    a[4 * k] = v0.x + gi * a[4 * k]; a[4 * k + 1] = v0.y + gi * a[4 * k + 1]; a[4 * k + 2] = v0.z + gi * a[4 * k + 2]; a[4 * k + 3] = v0.w + gi * a[4 * k + 3];
    b[4 * k] = v1.x + gi * b[4 * k]; b[4 * k + 1] = v1.y + gi * b[4 * k + 1]; b[4 * k + 2] = v1.z + gi * b[4 * k + 2]; b[4 * k + 3] = v1.w + gi * b[4 * k + 3];
  }
}
DI void phase_attn_nsa(const Params& P, bf16_t* og, unsigned char* smem, int L, int G) {
  bf16_t* big = (bf16_t*)(P.ws + OFF_BIG);
  const int gi = otid() >> 8;
  smem += gi * ATT_LDS;
  bf16_t* sK = (bf16_t*)smem; bf16_t* sVt = sK + 64 * 72;
  float* impL = (float*)(smem + 37376);
  float* scoreL = impL + 4 * 32 * 33;
  unsigned* selL = (unsigned*)(smem + 36864);
  float* totL = (float*)(smem + 37376);
  const float sc = 0.125f * LOG2E;
  for (int it = L; it < 4096; it += G) {
    int tid = threadIdx.x;
    asm volatile("" : "+v"(tid));
    tid &= 255;
    const int lane = tid & 63, w = tid >> 6, r = lane & 31, h = lane >> 5;
    int qt, bg; gqa_item(it, L, G, gi, qt, bg);
    const int b = bg >> 2, g = bg & 3;
    const int t0 = qt * 32, t = t0 + r, head = g * 4 + w;
    const size_t tok = (size_t)b * SEQ + t;
    bf16x8 qf[4];
#pragma unroll
    for (int ks = 0; ks < 4; ++ks) qf[ks] = *(const bf16x8*)(big + NS_Q + tok * 1024 + head * 64 + ks * 16 + 8 * h);
    const bf16_t* glp = big + NS_GL + tok * 64;
    const float g0 = sigmoidf_(bf2f(glp[head])), g1 = sigmoidf_(bf2f(glp[16 + head])), g2 = sigmoidf_(bf2f(glp[32 + head]));
    f32x16 o0, o1, s[2];
    {
      const bf16_t* kb = big + NS_KC2 + (size_t)((b * 4 + g) * 128) * 64;
      const bf16_t* vb = big + NS_VCT + (size_t)((b * 4 + g) * 64) * 128;
      float m = NEGF, l = 0.f;
      KVR R, R2;
      kv64_fetch(R, kb, 64, vb, 128, 0, true, tid);
      kv64_fetch(R2, kb, 64, vb, 128, 64, true, tid);
      __syncthreads();
      kv64_store(R, sK, sVt, tid);
      kv64_store(R2, sK + KVB64, sVt + KVB64, tid);
      __syncthreads();
#pragma unroll
      for (int tile = 0; tile < 2; ++tile) {
        const int key0 = tile * 64;
        auto mf = [&](int kk) { return (key0 + kk) * 16 + 31 <= t; };
        attn_step<64, true, 1>(sK + tile * KVB64, sVt + tile * KVB64, qf, o0, o1, m, l, sc, mf, lane, s, 0.f);
      }
      const float invl = l > 0.f ? 1.f / l : 0.f;
      o_zero(o0, o1);
      float cprev = 0.f;
#pragma unroll
      for (int tile = 0; tile < 2; ++tile) {
        const int key0 = tile * 64;
        auto mf = [&](int kk) { return (key0 + kk) * 16 + 31 <= t; };
        float l2 = 0.f;
        attn_step<64, true, 2>(sK + tile * KVB64, sVt + tile * KVB64, qf, o0, o1, m, l2, sc, mf, lane, s, invl);
#pragma unroll
        for (int sub = 0; sub < 2; ++sub)
#pragma unroll
          for (int s2 = 0; s2 < 2; ++s2) {
            const int Gi = tile * 4 + sub * 2 + s2;
            const int q0 = 8 * s2;
            const float Aj = s[sub][q0] + s[sub][q0 + 1] + s[sub][q0 + 2] + s[sub][q0 + 3];
            const float Bj = s[sub][q0 + 4] + s[sub][q0 + 5] + s[sub][q0 + 6] + s[sub][q0 + 7] + s[sub][q0 + 3];
            const float cx = shx(s[sub][q0 + 7], 32);
            const float add = h ? cx : cprev;
            cprev = cx;
            impL[(w * 32 + r) * 33 + 4 * Gi + 2 * h] = Aj + add;
            impL[(w * 32 + r) * 33 + 4 * Gi + 2 * h + 1] = Bj;
          }
      }
    }
    __syncthreads();
#pragma unroll
    for (int pss = 0; pss < 4; ++pss) {
      const int pair = pss * 256 + tid, q = pair >> 5, j = pair & 31;
      scoreL[q * 33 + j] = impL[(0 * 32 + q) * 33 + j] + impL[(1 * 32 + q) * 33 + j] + impL[(2 * 32 + q) * 33 + j] + impL[(3 * 32 + q) * 33 + j];
    }
    __syncthreads();
#pragma unroll
    for (int pss = 0; pss < 4; ++pss) {
      const int pair = pss * 256 + tid, q = pair >> 5, j = pair & 31;
      const int tq = t0 + q, cur = tq >> 6;
      const bool forced = (j == 0) || (j == cur) || (j == cur - 1);
      const int nf = cur >= 2 ? 3 : cur + 1;
      const int need = 8 - nf;
      const bool cand = (j >= 1) && (j <= cur - 2);
      const float sj = scoreL[q * 33 + j];
      int rank = 0;
      for (int j2 = 1; j2 <= cur - 2; ++j2) {
        const float s2v = scoreL[q * 33 + j2];
        rank += (s2v > sj || (s2v == sj && j2 < j)) ? 1 : 0;
      }
      const bool selected = forced || (cand && rank < need);
      const unsigned long long bal = __ballot(selected);
      if (j == 0) selL[q] = (unsigned)(bal >> (32 * (lane >> 5)));
    }
    __syncthreads();
    const unsigned sel = selL[r];
    unsigned selU = sel;
    selU |= (unsigned)__shfl_xor((int)selU, 1, 64); selU |= (unsigned)__shfl_xor((int)selU, 2, 64); selU |= (unsigned)__shfl_xor((int)selU, 4, 64);
    selU |= (unsigned)__shfl_xor((int)selU, 8, 64); selU |= (unsigned)__shfl_xor((int)selU, 16, 64);
    selU = (unsigned)__builtin_amdgcn_readfirstlane((int)selU);
    tot_store(totL, tid, o0, o1, g0);
    {
      const bf16_t* kb = big + NS_KS + (size_t)b * SEQ * 256 + g * 64;
      const bf16_t* vb = big + NS_VST + (size_t)((b * 4 + g) * 64) * SEQ;
      float m = NEGF, l = 0.f; o_zero(o0, o1);
      const int jhi = (t0 + 31) >> 6;
      KVR R; kv64_fetch(R, kb, 256, vb, SEQ, 0, true, tid);
      __syncthreads();
      kv64_store(R, sK, sVt, tid);
      if (0 < jhi) kv64_fetch(R, kb, 256, vb, SEQ, 64, true, tid);
      for (int j = 0; j <= jhi; ++j) {
        const int key0 = j * 64, cb = j & 1;
        __syncthreads();
        if (j < jhi) kv64_store(R, sK + (cb ^ 1) * KVB64, sVt + (cb ^ 1) * KVB64, tid);
        if (j + 1 < jhi) kv64_fetch(R, kb, 256, vb, SEQ, key0 + 128, true, tid);
        __builtin_amdgcn_sched_barrier(0);
        if ((selU >> j) & 1u) {
          const bool lsel = (sel >> j) & 1u;
          auto mf = [&](int kk) { return lsel && (key0 + kk <= t); };
          if (key0 + 63 > t0) attn_step<64, true, 0>(sK + cb * KVB64, sVt + cb * KVB64, qf, o0, o1, m, l, sc, mf, lane, s, 0.f);
          else attn_step<64, false, 0>(sK + cb * KVB64, sVt + cb * KVB64, qf, o0, o1, m, l, sc, mf, lane, s, 0.f, lsel);
        }
      }
      tot_addto(totL, tid, o0, o1, g1 / l);
      tot_store(totL, tid, o0, o1, 1.f);
    }
    {
      const bf16_t* kb = big + NS_KW + (size_t)b * SEQ * 256 + g * 64;
      const bf16_t* vb = big + NS_VWT + (size_t)((b * 4 + g) * 64) * SEQ;
      float m = NEGF, l = 0.f; o_zero(o0, o1);
      const int jlo = (t0 - 511 > 0 ? t0 - 511 : 0) >> 6, jhi = (t0 + 31) >> 6;
      KVR R; kv64_fetch(R, kb, 256, vb, SEQ, jlo * 64, true, tid);
      __syncthreads();
      kv64_store(R, sK, sVt, tid);
      if (jlo < jhi) kv64_fetch(R, kb, 256, vb, SEQ, jlo * 64 + 64, true, tid);
      for (int j = jlo; j <= jhi; ++j) {
        const int key0 = j * 64, cb = (j - jlo) & 1;
        __syncthreads();
        if (j < jhi) kv64_store(R, sK + (cb ^ 1) * KVB64, sVt + (cb ^ 1) * KVB64, tid);
        if (j + 1 < jhi) kv64_fetch(R, kb, 256, vb, SEQ, key0 + 128, true, tid);
        __builtin_amdgcn_sched_barrier(0);
        auto mf = [&](int kk) { const int key = key0 + kk; return key <= t && key > t - 512; };
        if (key0 + 63 > t0 || key0 <= t0 + 31 - 512) attn_step<64, true, 0>(sK + cb * KVB64, sVt + cb * KVB64, qf, o0, o1, m, l, sc, mf, lane, s, 0.f);
        else attn_step<64, false, 0>(sK + cb * KVB64, sVt + cb * KVB64, qf, o0, o1, m, l, sc, mf, lane, s, 0.f);
      }
      tot_addto(totL, tid, o0, o1, g2 / l);
    }
    __syncthreads();
    attn_write_staged(o0, o1, og, big + NS_Z, (size_t)b * SEQ + t0, head, lane, sK + w * (32 * 72));
    __syncthreads();
  }
}

template <bool XF32>
DI void phase_outproj(const Params& P, int layer, const void* xres, const bf16_t* og, unsigned char* smem, int L, int G) {
  bf16_t* Sb = (bf16_t*)(P.ws + OFF_BIG);
  float* stats = (float*)(P.ws + OFF_STATS);
  const bf16_t* Bt = (const bf16_t*)(P.ws + OFF_WOUTT) + (size_t)layer * 1024 * 1024;
  bf16_t* stg = (bf16_t*)smem;
  GR R;
  ARowPlain ar{og, 1024};
  if (L < 256 * 4) gemm_first<false>(R, ar, Bt, 1024, (L >> 2) * 256, (L & 3) * 256);
  for (int t = L; t < 256 * 4; t += G) {
    const int mt = t >> 2, nt = t & 3;
    const int tid = otid();
    const int lane = tid & 63, w = tid >> 6, r = lane & 31, h = lane >> 5;
    const int wm = w >> 2, wn = w & 3;
    f32x16 acc[4][2]; acc_zero(acc);
    gemm_loop<false>(acc, R, ar, Bt, 1024, mt * 256, nt * 256, 16, (bf16_t*)smem, true);
    if (t + G < 256 * 4) gemm_first<false>(R, ar, Bt, 1024, ((t + G) >> 2) * 256, ((t + G) & 3) * 256);
    __builtin_amdgcn_sched_barrier(0);
    stage_load_tile<true>(stg, (const bf16_t*)xres + (size_t)mt * 256 * 1024 + nt * 256);
    __syncthreads();
#pragma unroll
    for (int j = 0; j < 2; ++j)
#pragma unroll
      for (int ch = 0; ch < 2; ++ch) {
        float s1 = 0.f, s2 = 0.f;
#pragma unroll
        for (int i = 2 * ch; i < 2 * ch + 2; ++i)
#pragma unroll
          for (int q4 = 0; q4 < 4; ++q4) {
            uint2* pp = (uint2*)(stg + (wn * 64 + j * 32 + r) * STG + wm * 128 + i * 32 + 8 * q4 + 4 * h);
            const uint2 xv = *pp;
            uint2 pk;
            pk.x = pack2(DN_ALPHA * bflo(xv.x) + acc[i][j][4 * q4], DN_ALPHA * bfhi(xv.x) + acc[i][j][4 * q4 + 1]);
            pk.y = pack2(DN_ALPHA * bflo(xv.y) + acc[i][j][4 * q4 + 2], DN_ALPHA * bfhi(xv.y) + acc[i][j][4 * q4 + 3]);
            *pp = pk;
            const float f0 = bflo(pk.x), f1 = bfhi(pk.x), f2 = bflo(pk.y), f3 = bfhi(pk.y);
            s1 += (f0 + f1) + (f2 + f3); s2 += (f0 * f0 + f1 * f1) + (f2 * f2 + f3 * f3);
            __builtin_amdgcn_sched_barrier(0);
          }
        s1 += shx(s1, 32); s2 += shx(s2, 32);
        if (h == 0) {
          const size_t row = (size_t)(mt * 256 + wn * 64 + j * 32 + r);
          *(float2*)(stats + row * 32 + (nt * 4 + wm * 2 + ch) * 2) = make_float2(s1, s2);
        }
      }
    __syncthreads();
    stage_store_tile(stg, Sb + (size_t)mt * 256 * 1024 + nt * 256);
    __syncthreads();
  }
}

template <bool LAST>
DI void phase_gate(const Params& P, int layer, unsigned char* smem, int L, int G) {
  const bf16_t* Sb = (const bf16_t*)(P.ws + OFF_BIG);
  const bf16_t* PPb = (const bf16_t*)(P.ws + OFF_BIG) + BG_PP;
  const float* stats = (const float*)(P.ws + OFF_STATS);
  const bf16_t* Bg = (const bf16_t*)(P.ws + OFF_PGT) + (size_t)layer * 1024 * 1024;
  const float* c1 = (const float*)(P.ws + OFF_C1) + layer * 1024;
  const float* c2 = (const float*)(P.ws + OFF_C2) + layer * 1024;
  const float* lg = P.ln_g + layer * 1024; const float* lb = P.ln_b + layer * 1024;
  bf16_t* xb = (bf16_t*)(P.ws + OFF_XB);
  float* rowA = (float*)(smem + LDS_ROW_OFF); float* rowB = rowA + 256;
  float* vecL = (float*)(smem + LDS_VEC_OFF);
  bf16_t* stg = (bf16_t*)smem;
  GR R;
  ARowPlain ars{Sb, 1024};
  for (int t = L; t < 256 * 4; t += G) {
    const int mt = t >> 2, nt = t & 3;
    const int tid = otid();
    const int lane = tid & 63, w = tid >> 6, r = lane & 31, h = lane >> 5;
    const int wm = w >> 2, wn = w & 3;
    if (tid < 256) {
      const f32x4* st = (const f32x4*)(stats + (size_t)(mt * 256 + tid) * 32);
      float a = 0.f, b2 = 0.f;
#pragma unroll
      for (int q = 0; q < 8; ++q) { const f32x4 v = st[q]; a += v.x + v.z; b2 += v.y + v.w; }
      const float mu = a * (1.f / 1024.f);
      const float var = b2 * (1.f / 1024.f) - mu * mu;
      rowA[tid] = mu; rowB[tid] = rsqrtf(fmaxf(var, 0.f) + 1e-5f);
      vecL[tid] = c1[nt * 256 + tid]; vecL[256 + tid] = c2[nt * 256 + tid]; vecL[512 + tid] = lg[nt * 256 + tid]; vecL[768 + tid] = lb[nt * 256 + tid];
    }
    f32x16 accu[4][2]; acc_zero(accu);
    if (t == L) gemm_first<false>(R, ars, Bg, 1024, mt * 256, nt * 256);
    gemm_loop<false>(accu, R, ars, Bg, 1024, mt * 256, nt * 256, 16, (bf16_t*)smem, true);
    if (t + G < 256 * 4) gemm_first<false>(R, ars, Bg, 1024, ((t + G) >> 2) * 256, ((t + G) & 3) * 256);
    __builtin_amdgcn_sched_barrier(0);
    unsigned gq[4][2][8];
#pragma unroll
    for (int i = 0; i < 4; ++i)
#pragma unroll
      for (int q4 = 0; q4 < 4; ++q4) {
        const int fl = wm * 128 + i * 32 + 8 * q4 + 4 * h;
        const f32x4 c1v = *(const f32x4*)(vecL + fl), c2v = *(const f32x4*)(vecL + 256 + fl);
        const float c1a[4] = {c1v.x, c1v.y, c1v.z, c1v.w}, c2a[4] = {c2v.x, c2v.y, c2v.z, c2v.w};
#pragma unroll
        for (int j = 0; j < 2; ++j) {
          const int lrow = wn * 64 + j * 32 + r;
          const float mu = rowA[lrow], rstd = rowB[lrow];
          float sg4[4];
#pragma unroll
          for (int e = 0; e < 4; ++e) sg4[e] = sigmoidf_(rstd * (accu[i][j][4 * q4 + e] - mu * c1a[e]) + c2a[e]);
          gq[i][j][2 * q4] = pack2(sg4[0], sg4[1]); gq[i][j][2 * q4 + 1] = pack2(sg4[2], sg4[3]);
        }
        __builtin_amdgcn_sched_barrier(0);
      }
    stage_load_tile<true>(stg, PPb + (size_t)mt * 256 * 1024 + nt * 256);
    __syncthreads();
    {
      const int tid1 = otid();
      const int lane1 = tid1 & 63, w1 = tid1 >> 6, r1 = lane1 & 31, h1 = lane1 >> 5, wm1 = w1 >> 2, wn1 = w1 & 3;
#pragma unroll
      for (int i = 0; i < 4; ++i)
#pragma unroll
        for (int q4 = 0; q4 < 4; ++q4) {
#pragma unroll
          for (int j = 0; j < 2; ++j) {
            const uint2 pv = *(const uint2*)(stg + (wn1 * 64 + j * 32 + r1) * STG + wm1 * 128 + i * 32 + 8 * q4 + 4 * h1);
            const unsigned g0 = gq[i][j][2 * q4], g1 = gq[i][j][2 * q4 + 1];
            gq[i][j][2 * q4] = pack2(bflo(g0) * bflo(pv.x), bfhi(g0) * bfhi(pv.x));
            gq[i][j][2 * q4 + 1] = pack2(bflo(g1) * bflo(pv.y), bfhi(g1) * bfhi(pv.y));
          }
          __builtin_amdgcn_sched_barrier(0);
        }
    }
    __syncthreads();
    stage_load_tile<false>(stg, Sb + (size_t)mt * 256 * 1024 + nt * 256);
    __syncthreads();
    const int tid2 = otid();
    const int lane2 = tid2 & 63, w2 = tid2 >> 6, r2 = lane2 & 31, h2 = lane2 >> 5, wm2 = w2 >> 2, wn2 = w2 & 3;
#pragma unroll
    for (int i = 0; i < 4; ++i)
#pragma unroll
      for (int q4 = 0; q4 < 4; ++q4) {
        const int fl = wm2 * 128 + i * 32 + 8 * q4 + 4 * h2;
        const int f0 = nt * 256 + fl;
        const f32x4 gv = *(const f32x4*)(vecL + 512 + fl), bv = *(const f32x4*)(vecL + 768 + fl);
        const float ga[4] = {gv.x, gv.y, gv.z, gv.w}, ba[4] = {bv.x, bv.y, bv.z, bv.w};
#pragma unroll
        for (int j = 0; j < 2; ++j) {
          const int lrow = wn2 * 64 + j * 32 + r2;
          const float mu = rowA[lrow], rstd = rowB[lrow];
          uint2* sp = (uint2*)(stg + lrow * STG + fl);
          const uint2 sv = *sp;
          const float sa[4] = {bflo(sv.x), bfhi(sv.x), bflo(sv.y), bfhi(sv.y)};
          float y[4];
          const float gg[4] = {bflo(gq[i][j][2 * q4]), bfhi(gq[i][j][2 * q4]), bflo(gq[i][j][2 * q4 + 1]), bfhi(gq[i][j][2 * q4 + 1])};
#pragma unroll
          for (int e = 0; e < 4; ++e) y[e] = (sa[e] - mu) * rstd * ga[e] + ba[e] + gg[e];
          if (LAST) { f32x4 o = {y[0], y[1], y[2], y[3]}; *(f32x4*)(P.out + (size_t)(mt * 256 + lrow) * 1024 + f0) = o; }
          else { uint2 pk; pk.x = pack2(y[0], y[1]); pk.y = pack2(y[2], y[3]); *sp = pk; }
        }
        __builtin_amdgcn_sched_barrier(0);
      }
    __syncthreads();
    if (!LAST) stage_store_tile(stg, xb + (size_t)mt * 256 * 1024 + nt * 256);
    __syncthreads();
  }
}

#define XB_TMO      128
#define XB_XCNT(j)  (256  + 64 * (j))
#define XB_XSUB(j)  (1280 + 64 * (j))
#define XB_XGEN(j)  (2304 + 64 * (j))
#define XB_TOP      3328
#define XB_TOPGEN   3392
#define XCD_BAR_WORDS 3456
#define XB_SPIN_CAP (1u << 22)
#define LAS __attribute__((address_space(3)))
DI unsigned xb_ld(unsigned* p) { return __hip_atomic_load(p, __ATOMIC_RELAXED, __HIP_MEMORY_SCOPE_AGENT); }
DI unsigned xb_add(unsigned* p, unsigned v) { return __hip_atomic_fetch_add(p, v, __ATOMIC_RELAXED, __HIP_MEMORY_SCOPE_AGENT); }
DI unsigned xb_xcc_id() { return (unsigned)__builtin_amdgcn_s_getreg((3 << 11) | 20) & 0xFu; }
#define XB_SPIN(cond, bar) do { unsigned _sp = 0; while (cond) { __builtin_amdgcn_s_sleep(1); \
    if ((++_sp & 255u) == 0u) { if (xb_ld(&(bar)[XB_TMO])) break; if (_sp > XB_SPIN_CAP) { atomicAdd(&(bar)[XB_TMO], 1u); break; } } } } while (0)
struct XcdBarrier { unsigned* bar; unsigned x; volatile LAS unsigned* st; };
DI XcdBarrier xcd_barrier_post(unsigned* bar, volatile LAS unsigned* st) {
  XcdBarrier b; b.bar = bar; b.x = xb_xcc_id(); b.st = st;
  if (threadIdx.x == 0) (void)xb_add(&bar[XB_XCNT(b.x)], 1u);
  return b;
}
DI void xcd_barrier_complete(unsigned* bar, unsigned x, unsigned& nloc, unsigned& nx) {
  const unsigned G = gridDim.x * gridDim.y * gridDim.z;
  unsigned sum, cnt, mine, sp = 0u;
  for (;;) {
    sum = 0u; cnt = 0u; mine = 0u;
#pragma unroll
    for (unsigned j = 0; j < 16; ++j) { const unsigned c = xb_ld(&bar[XB_XCNT(j)]); sum += c; cnt += (c > 0u) ? 1u : 0u; mine = (j == x) ? c : mine; }
    if (sum == G) break;
    __builtin_amdgcn_s_sleep(1);
    if ((++sp & 255u) == 0u) { if (xb_ld(&bar[XB_TMO])) break; if (sp > XB_SPIN_CAP) { atomicAdd(&bar[XB_TMO], 1u); break; } }
  }
  nloc = mine > 0u ? mine : 1u; nx = cnt > 0u ? cnt : 1u;
}
DI void xcd_barrier(const XcdBarrier& b) {
  asm volatile("s_waitcnt vmcnt(0)" ::: "memory");
  __syncthreads();
  if (threadIdx.x == 0) {
    unsigned* bar = b.bar;
    __builtin_amdgcn_s_waitcnt(0);
    unsigned nloc = b.st[0], nx = b.st[1];
    if (nloc == 0u) { xcd_barrier_complete(bar, b.x, nloc, nx); b.st[0] = nloc; b.st[1] = nx; }
    const unsigned old = xb_add(&bar[XB_XSUB(b.x)], 1u);
    const unsigned gen = old / nloc;
    if (old + 1u == (gen + 1u) * nloc) {
      __builtin_amdgcn_fence(__ATOMIC_RELEASE, "agent");
      asm volatile("s_waitcnt vmcnt(0)" ::: "memory");
      const unsigned og = xb_add(&bar[XB_TOP], 1u);
      const unsigned tg = og / nx;
      if (og + 1u == (tg + 1u) * nx) xb_add(&bar[XB_TOPGEN], 1u);
      else XB_SPIN(xb_ld(&bar[XB_TOPGEN]) == tg, bar);
      __builtin_amdgcn_fence(__ATOMIC_ACQUIRE, "agent");
      xb_add(&bar[XB_XGEN(b.x)], 1u);
      asm volatile("s_waitcnt vmcnt(0)" ::: "memory");
    } else {
      XB_SPIN(xb_ld(&bar[XB_XGEN(b.x)]) == gen, bar);
      __builtin_amdgcn_fence(__ATOMIC_ACQUIRE, "agent");
      asm volatile("s_waitcnt vmcnt(0)" ::: "memory");
    }
  }
  __syncthreads();
}

__global__ void __launch_bounds__(512, 2) mega_fwd(Params P) {
  __shared__ __attribute__((aligned(16))) unsigned char smem[LDS_BYTES];
  __shared__ uint4 xb_words;
  cg::grid_group grid = cg::this_grid();
  if (P.ws == nullptr) grid.sync();
  if (threadIdx.x == 0) xb_words = make_uint4(0u, 0u, 0u, 0u);
  __syncthreads();
  XcdBarrier xbar = xcd_barrier_post((unsigned*)(P.ws + OFF_BAR), (volatile LAS unsigned*)&xb_words);
  const int G = gridDim.x, L = logical_bid();
  unsigned char* ws = P.ws;
  bf16_t* og = (bf16_t*)P.out;
  const bf16_t* xb = (const bf16_t*)(ws + OFF_XB);

  phase_prep(P, smem, L, G);
  xcd_barrier(xbar);

  phase_inproj_impl<false>(xb, 1024, 16, (const bf16_t*)(ws + OFF_WIN0T), 10, 0, P, smem, L, G);
  xcd_barrier(xbar);
  phase_attn_swa(P, P.l0_sinks, og, smem, L, G);
  xcd_barrier(xbar);
  phase_outproj<false>(P, 0, xb, og, smem, L, G);
  phase_inproj_impl<false>((const bf16_t*)(ws + OFF_PB) + (size_t)0 * MTOK * 256, 256, 4, (const bf16_t*)(ws + OFF_PPT) + (size_t)0 * 1024 * 256, 4, 5, P, smem, L, G);
  xcd_barrier(xbar);
  phase_gate<false>(P, 0, smem, L, G);
  xcd_barrier(xbar);
  phase_inproj_impl<false>(xb, 1024, 16, (const bf16_t*)(ws + OFF_WIN1T), 7, 1, P, smem, L, G);
  xcd_barrier(xbar);
  phase_mla_up(P, smem, L, G);
  xcd_barrier(xbar);
  phase_attn_mla(P, og, smem, L, G);
  xcd_barrier(xbar);
  phase_outproj<false>(P, 1, xb, og, smem, L, G);
  phase_inproj_impl<false>((const bf16_t*)(ws + OFF_PB) + (size_t)1 * MTOK * 256, 256, 4, (const bf16_t*)(ws + OFF_PPT) + (size_t)1 * 1024 * 256, 4, 5, P, smem, L, G);
  xcd_barrier(xbar);
  phase_gate<false>(P, 1, smem, L, G);
  xcd_barrier(xbar);
  phase_inproj_impl<false>(xb, 1024, 16, (const bf16_t*)(ws + OFF_WIN2T), 15, 2, P, smem, L, G);
  xcd_barrier(xbar);
  phase_cmp1(P, smem, L, G);
  xcd_barrier(xbar);
  phase_cmp2(P, smem, L, G);
  xcd_barrier(xbar);
  phase_attn_nsa(P, og, smem, L, G);
  xcd_barrier(xbar);
  phase_outproj<false>(P, 2, xb, og, smem, L, G);
  phase_inproj_impl<false>((const bf16_t*)(ws + OFF_PB) + (size_t)2 * MTOK * 256, 256, 4, (const bf16_t*)(ws + OFF_PPT) + (size_t)2 * 1024 * 256, 4, 5, P, smem, L, G);
  xcd_barrier(xbar);
  phase_gate<false>(P, 2, smem, L, G);
  xcd_barrier(xbar);
  phase_inproj_impl<false>(xb, 1024, 16, (const bf16_t*)(ws + OFF_WIN3T), 10, 0, P, smem, L, G);
  xcd_barrier(xbar);
  phase_attn_swa(P, P.l3_sinks, og, smem, L, G);
  xcd_barrier(xbar);
  phase_outproj<false>(P, 3, xb, og, smem, L, G);
  phase_inproj_impl<false>((const bf16_t*)(ws + OFF_PB) + (size_t)3 * MTOK * 256, 256, 4, (const bf16_t*)(ws + OFF_PPT) + (size_t)3 * 1024 * 256, 4, 5, P, smem, L, G);
  xcd_barrier(xbar);
  phase_gate<true>(P, 3, smem, L, G);
}

extern "C" void kernel_launch(void* const* d_in, const int* in_sizes, int n_in, void* d_out, int out_size, void* d_ws, size_t ws_size,
                              hipStream_t stream) {
  static int grid_blocks = 0;
  if (!grid_blocks) {
    int dev = 0, cus = 0, per_cu = 0;
    hipGetDevice(&dev);
    hipDeviceGetAttribute(&cus, hipDeviceAttributeMultiprocessorCount, dev);
    hipOccupancyMaxActiveBlocksPerMultiprocessor(&per_cu, mega_fwd, NTHR, 0);
    per_cu = 1;
    grid_blocks = cus * per_cu;
    if (ws_size < WS_NEED) fprintf(stderr, "kernel_launch: workspace too small: %zu < %zu\n", ws_size, (size_t)WS_NEED);
  }
  Params p{};
  p.x = (const float*)d_in[0]; p.p = (const float*)d_in[1]; p.pos = (const int*)d_in[2]; p.w_out = (const float*)d_in[3];
  p.ln_g = (const float*)d_in[4]; p.ln_b = (const float*)d_in[5]; p.pe_gate = (const float*)d_in[6]; p.pe_proj = (const float*)d_in[7];
  p.l0_w_in = (const float*)d_in[8]; p.l0_sinks = (const float*)d_in[9];
  p.l1_w_in = (const float*)d_in[10]; p.l1_q_norm = (const float*)d_in[11]; p.l1_kv_norm = (const float*)d_in[12];
  p.l1_w_uq = (const float*)d_in[13]; p.l1_w_ukv = (const float*)d_in[14];
  p.l2_w_in = (const float*)d_in[15]; p.l2_cmp_pos = (const float*)d_in[16]; p.l2_phi_k1 = (const float*)d_in[17]; p.l2_phi_k2 = (const float*)d_in[18];
  p.l2_phi_v1 = (const float*)d_in[19]; p.l2_phi_v2 = (const float*)d_in[20];
  p.l3_w_in = (const float*)d_in[21]; p.l3_sinks = (const float*)d_in[22];
  p.out = (float*)d_out; p.ws = (unsigned char*)d_ws;
  (void)hipMemsetAsync((unsigned char*)d_ws + OFF_BAR, 0, 16384, stream);
  void* args[] = {&p};
  hipError_t e = hipLaunchCooperativeKernel((void*)mega_fwd, dim3(grid_blocks), dim3(NTHR), args, 0, stream);
  if (e != hipSuccess) fprintf(stderr, "cooperative launch failed: %s (grid %d)\n", hipGetErrorString(e), grid_blocks);
}
```

```cpp
#include <hip/hip_runtime.h>
#include <hip/hip_cooperative_groups.h>
#include <stdint.h>
#include <stdio.h>
namespace cg = cooperative_groups;

typedef __attribute__((ext_vector_type(8))) short bf16x8;
typedef __attribute__((ext_vector_type(16))) float f32x16;
typedef __attribute__((ext_vector_type(2))) float f32x2_t;
typedef __attribute__((ext_vector_type(2))) __bf16 bf16x2_t;
typedef unsigned short bf16_t;

#define DI __device__ __forceinline__
#define MFMA(a, b, c) __builtin_amdgcn_mfma_f32_32x32x16_bf16((a), (b), (c), 0, 0, 0)

constexpr int SEQ = 2048;
constexpr int NB = 32;
constexpr int MTOK = NB * SEQ;
constexpr int DM = 1024;
constexpr float LOG2E = 1.4426950408889634f;
constexpr float NEGF = -1e30f;
constexpr float DN_ALPHA = 1.681792830507429f;

constexpr size_t al256(size_t x) { return (x + 255) & ~(size_t)255; }
constexpr size_t OFF_WIN0T = 0;
constexpr size_t OFF_WIN1T = OFF_WIN0T + (size_t)2560 * 1024 * 2;
constexpr size_t OFF_WIN2T = OFF_WIN1T + (size_t)1792 * 1024 * 2;
constexpr size_t OFF_WIN3T = OFF_WIN2T + (size_t)3840 * 1024 * 2;
constexpr size_t OFF_WUQT = OFF_WIN3T + (size_t)2560 * 1024 * 2;
constexpr size_t OFF_WUKVT = OFF_WUQT + (size_t)1536 * 384 * 2;
constexpr size_t OFF_PK1T = OFF_WUKVT + (size_t)2048 * 256 * 2;
constexpr size_t OFF_PV1T = OFF_PK1T + (size_t)256 * 2048 * 2;
constexpr size_t OFF_PK2T = OFF_PV1T + (size_t)256 * 2048 * 2;
constexpr size_t OFF_PV2T = OFF_PK2T + (size_t)256 * 256 * 2;
constexpr size_t OFF_WOUTT = OFF_PV2T + (size_t)256 * 256 * 2;
constexpr size_t OFF_PGT = OFF_WOUTT + (size_t)4 * 1024 * 1024 * 2;
constexpr size_t OFF_PPT = OFF_PGT + (size_t)4 * 1024 * 1024 * 2;
constexpr size_t OFF_C1 = OFF_PPT + (size_t)4 * 1024 * 256 * 2;
constexpr size_t OFF_C2 = OFF_C1 + 4 * 1024 * 4;
constexpr size_t OFF_BIAS = OFF_C2 + 4 * 1024 * 4;
constexpr size_t OFF_CS64 = OFF_BIAS + 2 * 256 * 4;
constexpr size_t OFF_CS32 = OFF_CS64 + (size_t)MTOK * 32 * 8;
constexpr size_t OFF_STATS = OFF_CS32 + (size_t)MTOK * 16 * 8;
constexpr size_t OFF_MSTAT = OFF_STATS + (size_t)MTOK * 32 * 4;
constexpr size_t OFF_XB = OFF_MSTAT + (size_t)MTOK * 16 * 4;
constexpr size_t OFF_BIG = OFF_XB + (size_t)MTOK * 1024 * 2;
constexpr size_t BIG_ELEMS = (size_t)MTOK * 5280;
constexpr size_t OFF_BAR = OFF_BIG + BIG_ELEMS * 2 + 65536;
constexpr size_t OFF_PB = OFF_BAR + 16384;
constexpr size_t WS_NEED = OFF_PB + (size_t)4 * MTOK * 256 * 2;

constexpr size_t MK = MTOK;
constexpr size_t BG_PP = MK * 1024;
constexpr size_t SW_Q = 0, SW_K = MK * 1024, SW_VT = MK * 1280, SW_Z = MK * 1536;
constexpr size_t ML_CQ = 0, ML_CKV = MK * 384, ML_Z = MK * 640, ML_KR = MK * 1664, ML_QN = MK * 1696, ML_QR = MK * 2720,
                 ML_KN = MK * 3232, ML_VT = MK * 4256;
constexpr size_t NS_Q = 0, NS_KCR = MK * 1024, NS_VCR = MK * 1280, NS_KS = MK * 1536, NS_VST = MK * 1792, NS_KW = MK * 2048,
                 NS_VWT = MK * 2304, NS_Z = MK * 2560, NS_GL = MK * 3584, NS_HK = MK * 3648, NS_HV = MK * 3712,
                 NS_KC2 = MK * 3776, NS_VCT = MK * 3792;

constexpr int NTHR = 512;
constexpr int LDS_TILE = 256 * 72;
constexpr int LDS_GEMM_BYTES = 4 * LDS_TILE * 2;
constexpr int LDS_ROW_OFF = LDS_GEMM_BYTES;
constexpr int LDS_VEC_OFF = LDS_GEMM_BYTES + 2048;
constexpr int LDS_BYTES = LDS_GEMM_BYTES + 2048 + 4096;
constexpr int ATT_LDS = 73728;

struct Params {
  const float* x; const float* p; const int* pos; const float* w_out; const float* ln_g; const float* ln_b;
  const float* pe_gate; const float* pe_proj;
  const float* l0_w_in; const float* l0_sinks;
  const float* l1_w_in; const float* l1_q_norm; const float* l1_kv_norm; const float* l1_w_uq; const float* l1_w_ukv;
  const float* l2_w_in; const float* l2_cmp_pos; const float* l2_phi_k1; const float* l2_phi_k2; const float* l2_phi_v1; const float* l2_phi_v2;
  const float* l3_w_in; const float* l3_sinks;
  float* out; unsigned char* ws;
};

DI unsigned pack2(float a, float b) { f32x2_t v = {a, b}; bf16x2_t r = __builtin_convertvector(v, bf16x2_t); return __builtin_bit_cast(unsigned, r); }
DI bf16_t f2bf(float a) { return (bf16_t)(pack2(a, 0.f) & 0xffffu); }
DI float bf2f(bf16_t b) { return __uint_as_float(((unsigned)b) << 16); }
DI float bflo(unsigned u) { return __uint_as_float(u << 16); }
DI float bfhi(unsigned u) { return __uint_as_float(u & 0xffff0000u); }
DI float fexp2(float x) { return __builtin_amdgcn_exp2f(x); }
DI float sigmoidf_(float x) { return __builtin_amdgcn_rcpf(1.f + __expf(-x)); }
DI float siluf_(float x) { return x * __builtin_amdgcn_rcpf(1.f + __expf(-x)); }
DI int crow(int reg, int h) { return (reg & 3) + 8 * (reg >> 2) + 4 * h; }
DI float shx(float v, int m) { return __shfl_xor(v, m, 64); }
DI int otid() { int t = threadIdx.x; asm volatile("" : "+v"(t)); return t; }

DI float rowsum16(const float (&v)[16], int c) {
  float w8[8], w4[4], w2[2];
  const bool b4 = c & 16, b3 = c & 8, b2 = c & 4, b1 = c & 2;
#pragma unroll
  for (int k = 0; k < 8; ++k) { float send = b4 ? v[k] : v[k + 8]; float keep = b4 ? v[k + 8] : v[k]; w8[k] = keep + shx(send, 16); }
#pragma unroll
  for (int k = 0; k < 4; ++k) { float send = b3 ? w8[k] : w8[k + 4]; float keep = b3 ? w8[k + 4] : w8[k]; w4[k] = keep + shx(send, 8); }
#pragma unroll
  for (int k = 0; k < 2; ++k) { float send = b2 ? w4[k] : w4[k + 2]; float keep = b2 ? w4[k + 2] : w4[k]; w2[k] = keep + shx(send, 4); }
  float send = b1 ? w2[0] : w2[1]; float keep = b1 ? w2[1] : w2[0];
  float w1 = keep + shx(send, 2);
  return w1 + shx(w1, 1);
}
DI int rowsum_idx(int c) { return ((c >> 4) & 1) * 8 + ((c >> 3) & 1) * 4 + ((c >> 2) & 1) * 2 + ((c >> 1) & 1); }

struct ARowPlain { const bf16_t* A; int lda; DI const bf16_t* operator()(int row, int kt) const { return A + (size_t)row * lda + kt * 64; } };
struct ARowF32 { const float* A; int lda; DI const float* operator()(int row, int kt) const { return A + (size_t)row * lda + kt * 64; } };
struct ARowCmp { const bf16_t* base; DI const bf16_t* operator()(int row, int kt) const {
  int b = row >> 9, n = (row >> 2) & 127, g = row & 3; return base + ((size_t)(b * SEQ + n * 16 + kt)) * 256 + g * 64; } };

typedef unsigned u32x4 __attribute__((ext_vector_type(4)));
typedef float f32x4 __attribute__((ext_vector_type(4)));
DI u32x4 ldg16(const void* p) { return *(const u32x4*)p; }
DI void stg16_nt(void* p, u32x4 v) { __builtin_nontemporal_store(v, (u32x4*)p); }
DI f32x4 ldgf4(const float* p) { return *(const f32x4*)p; }
DI u32x4 cvt8(f32x4 a, f32x4 b) { u32x4 r; r.x = pack2(a.x, a.y); r.y = pack2(a.z, a.w); r.z = pack2(b.x, b.y); r.w = pack2(b.z, b.w); return r; }

struct GR { u32x4 a0, a1, a2, a3, b0, b1, b2, b3; };
#define GL_LOADA(i, kt) { R.a##i = ldg16((const bf16_t*)ar(m0 + lrow + 64 * i, kt) + lkc * 8); \
                          R.b##i = ldg16(Bt + (size_t)(n0 + lrow + 64 * i) * ldb + (kt) * 64 + lkc * 8); }
#define GL_STORE(i) { *(u32x4*)(sA + (lrow + 64 * i) * 72 + lkc * 8) = R.a##i; *(u32x4*)(sB + (lrow + 64 * i) * 72 + lkc * 8) = R.b##i; }

template <bool AF32, class AR>
DI void gemm_first(GR& R, const AR& ar, const bf16_t* __restrict__ Bt, int ldb, int m0, int n0) {
  const int tid = otid();
  const int lrow = tid >> 3, lkc = tid & 7;
  GL_LOADA(0, 0) GL_LOADA(1, 0) GL_LOADA(2, 0) GL_LOADA(3, 0)
}

template <bool AF32, class AR>
DI void gemm_loop(f32x16 (&acc)[4][2], GR& R, const AR& ar, const bf16_t* __restrict__ Bt, int ldb, int m0, int n0, int nk, bf16_t* lds, bool swp) {
  const int tid = otid();
  const int lane = tid & 63, w = tid >> 6, r = lane & 31, h = lane >> 5;
  const int wm = w >> 2, wn = w & 3;
  const int lrow = tid >> 3, lkc = tid & 7;
  {
    bf16_t* sA = lds; bf16_t* sB = lds + 2 * LDS_TILE;
    GL_STORE(0) GL_STORE(1) GL_STORE(2) GL_STORE(3)
  }
  if (1 < nk) { GL_LOADA(0, 1) GL_LOADA(1, 1) GL_LOADA(2, 1) GL_LOADA(3, 1) }
  __syncthreads();
  for (int kt = 0; kt < nk; ++kt) {
    if (kt + 1 < nk) {
      bf16_t* sA = lds + ((kt + 1) & 1) * LDS_TILE;
      bf16_t* sB = lds + 2 * LDS_TILE + ((kt + 1) & 1) * LDS_TILE;
      GL_STORE(0) GL_STORE(1) GL_STORE(2) GL_STORE(3)
    }
    if (kt + 2 < nk) { GL_LOADA(0, kt + 2) GL_LOADA(1, kt + 2) GL_LOADA(2, kt + 2) GL_LOADA(3, kt + 2) }
    __builtin_amdgcn_sched_barrier(0);
    const bf16_t* sA = lds + (kt & 1) * LDS_TILE;
    const bf16_t* sB = lds + 2 * LDS_TILE + (kt & 1) * LDS_TILE;
    {
      const bf16_t* pa = (swp ? sB : sA) + (wm * 128 + r) * 72 + 8 * h;
      const bf16_t* pb = (swp ? sA : sB) + (wn * 64 + r) * 72 + 8 * h;
#define FR_LOAD(ks, P) { P##a0 = *(const bf16x8*)(pa + (ks) * 16); P##a1 = *(const bf16x8*)(pa + 32 * 72 + (ks) * 16); \
                         P##a2 = *(const bf16x8*)(pa + 64 * 72 + (ks) * 16); P##a3 = *(const bf16x8*)(pa + 96 * 72 + (ks) * 16); \
                         P##b0 = *(const bf16x8*)(pb + (ks) * 16); P##b1 = *(const bf16x8*)(pb + 32 * 72 + (ks) * 16); }
#define FR_MMA(P) { acc[0][0] = MFMA(P##a0, P##b0, acc[0][0]); acc[0][1] = MFMA(P##a0, P##b1, acc[0][1]); \
                    acc[1][0] = MFMA(P##a1, P##b0, acc[1][0]); acc[1][1] = MFMA(P##a1, P##b1, acc[1][1]); \
                    acc[2][0] = MFMA(P##a2, P##b0, acc[2][0]); acc[2][1] = MFMA(P##a2, P##b1, acc[2][1]); \
                    acc[3][0] = MFMA(P##a3, P##b0, acc[3][0]); acc[3][1] = MFMA(P##a3, P##b1, acc[3][1]); }
#pragma unroll
      for (int ks = 0; ks < 4; ++ks) {
        bf16x8 xa0, xa1, xa2, xa3, xb0, xb1;
        FR_LOAD(ks, x)
        FR_MMA(x)
      }
    }
    __syncthreads();
  }
}

DI void acc_zero(f32x16 (&acc)[4][2]) {
#pragma unroll
  for (int i = 0; i < 4; ++i)
#pragma unroll
    for (int j = 0; j < 2; ++j)
#pragma unroll
      for (int q = 0; q < 16; ++q) acc[i][j][q] = 0.f;
}

enum { K_PLAIN = 0, K_ROPE64 = 1, K_ROPE32 = 2, K_VT = 3, K_SILU = 4, K_KC2 = 5, K_VCT = 6, K_NONE = 7 };
struct Seg {
  int kind; bf16_t* dst; int ld; int cbase; int G; int nvalid;
  float* stat; int statbase;
  const float* bias;
};
DI bool seg_swapped(int kind) { return kind != K_VT && kind != K_VCT; }

constexpr int STG = 260;
DI void stage_acc(bf16_t* stg, const f32x16 (&acc)[4][2], int wm, int wn, int r, int h) {
#pragma unroll
  for (int i = 0; i < 4; ++i)
#pragma unroll
    for (int j = 0; j < 2; ++j)
#pragma unroll
      for (int q4 = 0; q4 < 4; ++q4) {
        uint2 pk;
        pk.x = pack2(acc[i][j][4 * q4], acc[i][j][4 * q4 + 1]);
        pk.y = pack2(acc[i][j][4 * q4 + 2], acc[i][j][4 * q4 + 3]);
        *(uint2*)(stg + (wn * 64 + j * 32 + r) * STG + wm * 128 + i * 32 + 8 * q4 + 4 * h) = pk;
      }
}
DI u32x4 stage_read16(const bf16_t* stg, int rr, int c) {
  const uint2 lo = *(const uint2*)(stg + rr * STG + c * 8);
  const uint2 hi = *(const uint2*)(stg + rr * STG + c * 8 + 4);
  u32x4 v; v.x = lo.x; v.y = lo.y; v.z = hi.x; v.w = hi.y; return v;
}
DI void stage_write16(bf16_t* stg, int rr, int c, u32x4 v) {
  *(uint2*)(stg + rr * STG + c * 8) = make_uint2(v.x, v.y);
  *(uint2*)(stg + rr * STG + c * 8 + 4) = make_uint2(v.z, v.w);
}
template <bool NT>
DI void stage_load_tile(bf16_t* stg, const bf16_t* tilebase) {
  const int tid = otid();
  const int r0 = tid >> 5, c = tid & 31;
  const unsigned o0 = (unsigned)(r0 * 1024 + c * 8);
  __builtin_amdgcn_sched_barrier(0);
#pragma unroll
  for (int hf = 0; hf < 2; ++hf) {
#pragma unroll
    for (int it = 8 * hf; it < 8 * hf + 8; ++it) {
      const u32x4* gp = (const u32x4*)(tilebase + (o0 + (unsigned)(it * 16 * 1024)));
      stage_write16(stg, r0 + 16 * it, c, NT ? __builtin_nontemporal_load(gp) : *gp);
    }
    __builtin_amdgcn_sched_barrier(0);
  }
}
DI void stage_store_tile(const bf16_t* stg, bf16_t* tilebase) {
  const int tid = otid();
  const int r0 = tid >> 5, c = tid & 31;
  const unsigned o0 = (unsigned)(r0 * 1024 + c * 8);
#pragma unroll
  for (int it = 0; it < 16; ++it) stg16_nt(tilebase + (o0 + (unsigned)(it * 16 * 1024)), stage_read16(stg, r0 + 16 * it, c));
}

DI void epi_seg(const f32x16 (&acc)[4][2], const Seg& sg0, const Seg& sg1, int m0, int n0, const float* rs, const float2* cs64, const float2* cs32, bf16_t* stg) {
  const int tid = otid();
  const int lane = tid & 63, w = tid >> 6, r = lane & 31, h = lane >> 5;
  const int wm = w >> 2, wn = w & 3;
  const int kind0 = sg0.kind;
  if (kind0 == K_VCT) {
    if (wn == 0) {
#pragma unroll
      for (int i = 0; i < 4; ++i)
#pragma unroll
        for (int q = 0; q < 16; ++q) {
          const int row = m0 + wm * 128 + i * 32 + crow(q, h);
          const int b = row >> 9, n = (row >> 2) & 127, g = row & 3;
#pragma unroll
          for (int j = 0; j < 2; ++j) sg0.dst[((size_t)((b * 4 + g) * 64 + j * 32 + r)) * 128 + n] = f2bf(acc[i][j][q]);
        }
    }
    __syncthreads();
    return;
  }
  if (kind0 == K_VT) {
#pragma unroll
    for (int i = 0; i < 4; ++i)
#pragma unroll
      for (int q4 = 0; q4 < 4; ++q4) {
        const int t0l = wm * 128 + i * 32 + 8 * q4 + 4 * h;
        float s0 = 1.f, s1 = 1.f, s2 = 1.f, s3 = 1.f;
        if (rs) { s0 = rs[t0l]; s1 = rs[t0l + 1]; s2 = rs[t0l + 2]; s3 = rs[t0l + 3]; }
#pragma unroll
        for (int j = 0; j < 2; ++j)
          *(uint2*)(stg + (wn * 64 + j * 32 + r) * STG + t0l) =
              make_uint2(pack2(acc[i][j][4 * q4] * s0, acc[i][j][4 * q4 + 1] * s1), pack2(acc[i][j][4 * q4 + 2] * s2, acc[i][j][4 * q4 + 3] * s3));
      }
    __syncthreads();
    const int b = m0 >> 11, s0 = m0 & (SEQ - 1);
#pragma unroll
    for (int it = 0; it < 16; ++it) {
      const int idx = tid + NTHR * it, rr = idx >> 5, c = idx & 31;
      const int lc = n0 + rr - sg0.cbase, g = lc >> 6, d = lc & 63;
      stg16_nt(sg0.dst + ((size_t)((b * sg0.G + g) * 64 + d)) * SEQ + s0 + c * 8, stage_read16(stg, rr, c));
    }
    __syncthreads();
    return;
  }
  const Seg& sg = wm ? sg1 : sg0;
  const int kind = sg.kind;
  const int lcw = n0 + wm * 128 - sg.cbase;
  const bool wvalid = (kind != K_NONE) && (lcw < sg.nvalid);
  if (wvalid) {
#pragma unroll
    for (int j = 0; j < 2; ++j) {
      const int lrow = wn * 64 + j * 32 + r;
      const float sc = rs ? rs[lrow] : 1.f;
      bf16_t* srow = stg + lrow * STG + wm * 128 + 4 * h;
      if (kind == K_ROPE64 || kind == K_KC2) {
        const int row = m0 + lrow;
        size_t tok = row;
        if (kind == K_KC2) { const int b = row >> 9, n = (row >> 2) & 127; int t = n * 16 + 31; if (t > SEQ - 1) t = SEQ - 1; tok = (size_t)b * SEQ + t; }
        const f32x4* cp = (const f32x4*)(cs64 + tok * 32);
#pragma unroll
        for (int q4 = 0; q4 < 4; ++q4) {
          const f32x4 c01 = cp[(8 * q4 + 4 * h) / 2], c23 = cp[(8 * q4 + 4 * h) / 2 + 1];
          const float cc[4] = {c01.x, c01.z, c23.x, c23.z}, sn[4] = {c01.y, c01.w, c23.y, c23.w};
#pragma unroll
          for (int hd = 0; hd < 2; ++hd) {
            float o1[4], o2[4];
#pragma unroll
            for (int e = 0; e < 4; ++e) {
              const float x1 = acc[2 * hd][j][4 * q4 + e], x2 = acc[2 * hd + 1][j][4 * q4 + e];
              o1[e] = x1 * cc[e] - x2 * sn[e]; o2[e] = x2 * cc[e] + x1 * sn[e];
            }
            *(uint2*)(srow + (2 * hd) * 32 + 8 * q4) = make_uint2(pack2(o1[0], o1[1]), pack2(o1[2], o1[3]));
            *(uint2*)(srow + (2 * hd + 1) * 32 + 8 * q4) = make_uint2(pack2(o2[0], o2[1]), pack2(o2[2], o2[3]));
          }
        }
      } else if (kind == K_ROPE32) {
        const size_t tok = (size_t)(m0 + lrow);
        const f32x4* cp = (const f32x4*)(cs32 + tok * 16);
#pragma unroll
        for (int q4 = 0; q4 < 2; ++q4) {
          const f32x4 c01 = cp[(8 * q4 + 4 * h) / 2], c23 = cp[(8 * q4 + 4 * h) / 2 + 1];
          const float cc[4] = {c01.x, c01.z, c23.x, c23.z}, sn[4] = {c01.y, c01.w, c23.y, c23.w};
#pragma unroll
          for (int i = 0; i < 4; ++i) {
            float o1[4], o2[4];
#pragma unroll
            for (int e = 0; e < 4; ++e) {
              const float x1 = acc[i][j][4 * q4 + e] * sc, x2 = acc[i][j][4 * q4 + e + 8] * sc;
              o1[e] = x1 * cc[e] - x2 * sn[e]; o2[e] = x2 * cc[e] + x1 * sn[e];
            }
            *(uint2*)(srow + i * 32 + 8 * q4) = make_uint2(pack2(o1[0], o1[1]), pack2(o1[2], o1[3]));
            *(uint2*)(srow + i * 32 + 8 * (q4 + 2)) = make_uint2(pack2(o2[0], o2[1]), pack2(o2[2], o2[3]));
          }
        }
      } else {
#pragma unroll
        for (int ch = 0; ch < 2; ++ch) {
          float ss = 0.f;
#pragma unroll
          for (int i = 2 * ch; i < 2 * ch + 2; ++i)
#pragma unroll
            for (int q4 = 0; q4 < 4; ++q4) {
              float v[4] = {acc[i][j][4 * q4] * sc, acc[i][j][4 * q4 + 1] * sc, acc[i][j][4 * q4 + 2] * sc, acc[i][j][4 * q4 + 3] * sc};
              if (kind == K_SILU) {
                const f32x4 bv = *(const f32x4*)(sg.bias + lcw + i * 32 + 8 * q4 + 4 * h);
                v[0] = siluf_(v[0] + bv.x); v[1] = siluf_(v[1] + bv.y); v[2] = siluf_(v[2] + bv.z); v[3] = siluf_(v[3] + bv.w);
              }
              const uint2 pk = make_uint2(pack2(v[0], v[1]), pack2(v[2], v[3]));
              *(uint2*)(srow + i * 32 + 8 * q4) = pk;
              const float f0 = bflo(pk.x), f1 = bfhi(pk.x), f2 = bflo(pk.y), f3 = bfhi(pk.y);
              ss += (f0 * f0 + f1 * f1) + (f2 * f2 + f3 * f3);
            }
          if (sg.stat) {
            ss += shx(ss, 32);
            if (h == 0 && lcw + ch * 64 < sg.nvalid) sg.stat[(size_t)(m0 + lrow) * 16 + sg.statbase + (lcw >> 6) + ch] = ss;
          }
        }
      }
    }
  }
  __syncthreads();
#pragma unroll
  for (int it = 0; it < 16; ++it) {
    const int idx = tid + NTHR * it, rr = idx >> 5, c = idx & 31;
    const Seg& fs = (c >> 4) ? sg1 : sg0;
    const int lcc = n0 + c * 8 - fs.cbase;
    if (fs.kind != K_NONE && lcc < fs.nvalid) {
      const int row = m0 + rr;
      size_t off;
      if (fs.kind == K_KC2) { const int b = row >> 9, n = (row >> 2) & 127, g = row & 3; off = ((size_t)((b * 4 + g) * 128 + n)) * 64 + lcc; }
      else off = (size_t)row * fs.ld + lcc;
      stg16_nt(fs.dst + off, stage_read16(stg, rr, c));
    }
  }
  __syncthreads();
}

DI int kperm(int r) { return (r & 0x13) | ((r & 8) >> 1) | ((r & 4) << 1); }

template <int DQK, bool MASKED, int MODE, class MF>
DI void attn_step(const bf16_t* sK, const bf16_t* sVt, const bf16x8 (&qf)[DQK / 16], f32x16& o0, f32x16& o1, float& m, float& l,
                  float sc, const MF& mf, int lane, f32x16 (&s)[2], float invl, bool lanevalid = true) {
  const int r = lane & 31, h = lane >> 5;
  const int pr = kperm(r);
  constexpr int KST = DQK + 8;
  bf16x8 kf[2][DQK / 16];
#pragma unroll
  for (int sub = 0; sub < 2; ++sub)
#pragma unroll
    for (int ks = 0; ks < DQK / 16; ++ks) kf[sub][ks] = *(const bf16x8*)(sK + (sub * 32 + pr) * KST + ks * 16 + 8 * h);
  __builtin_amdgcn_sched_barrier(0);
#pragma unroll
  for (int q = 0; q < 16; ++q) { s[0][q] = 0.f; s[1][q] = 0.f; }
#pragma unroll
  for (int ks = 0; ks < DQK / 16; ++ks) {
    s[0] = MFMA(kf[0][ks], qf[ks], s[0]);
    s[1] = MFMA(kf[1][ks], qf[ks], s[1]);
  }
  bf16x8 vf[2][2][2];
  if (MODE != 1) {
#pragma unroll
    for (int sub = 0; sub < 2; ++sub)
#pragma unroll
      for (int s2 = 0; s2 < 2; ++s2) {
        vf[sub][s2][0] = *(const bf16x8*)(sVt + r * 72 + sub * 32 + s2 * 16 + 8 * h);
        vf[sub][s2][1] = *(const bf16x8*)(sVt + (32 + r) * 72 + sub * 32 + s2 * 16 + 8 * h);
      }
    __builtin_amdgcn_sched_barrier(0);
  }
  float mxr = -3.0e38f;
#pragma unroll
  for (int sub = 0; sub < 2; ++sub)
#pragma unroll
    for (int q = 0; q < 16; ++q) {
      if (MASKED) { const int kk = sub * 32 + 16 * (q >> 3) + 8 * h + (q & 7); s[sub][q] = mf(kk) ? s[sub][q] : -3.0e38f; }
      if (MODE != 2) mxr = fmaxf(mxr, s[sub][q]);
    }
  float alpha = 1.f;
  if (MODE != 2) {
    float mx = fmaxf(m, mxr * sc);
    mx = fmaxf(mx, shx(mx, 32));
    if (!MASKED) mx = lanevalid ? mx : m;
    alpha = fexp2(m - mx);
    m = mx;
  }
  const float moff = (!MASKED && !lanevalid) ? 1.0e30f : m;
  float ps = 0.f;
#pragma unroll
  for (int sub = 0; sub < 2; ++sub)
#pragma unroll
    for (int q = 0; q < 16; ++q) {
      float pv = fexp2(__builtin_fmaf(s[sub][q], sc, -moff));
      if (MASKED && MODE != 0) pv = (s[sub][q] > -1.0e38f) ? pv : 0.f;
      if (MODE == 2) pv *= invl;
      s[sub][q] = pv;
      ps += pv;
    }
  if (MODE != 2) {
    ps += shx(ps, 32);
    l = l * alpha + ps;
  }
  if (MODE == 1) return;
  if (MODE == 0) {
#pragma unroll
    for (int q = 0; q < 16; ++q) { o0[q] *= alpha; o1[q] *= alpha; }
  }
#pragma unroll
  for (int sub = 0; sub < 2; ++sub)
#pragma unroll
    for (int s2 = 0; s2 < 2; ++s2) {
      union { bf16x8 v; unsigned u[4]; } pb;
#pragma unroll
      for (int e = 0; e < 4; ++e) pb.u[e] = pack2(s[sub][8 * s2 + 2 * e], s[sub][8 * s2 + 2 * e + 1]);
      o0 = MFMA(vf[sub][s2][0], pb.v, o0);
      o1 = MFMA(vf[sub][s2][1], pb.v, o1);
    }
}

constexpr int KVB64 = 2 * 64 * 72;
constexpr int KVB96 = 64 * 104 + 64 * 72;
struct KVR { u32x4 k0, k1, k2, v0, v1; };
DI void kv64_fetch(KVR& R, const bf16_t* kbase, int kstride, const bf16_t* vtbase, int vtstride, int key0, bool withV, int tid) {
  const int row0 = tid >> 3, kc = tid & 7, row1 = row0 + 32;
  R.k0 = ldg16(kbase + (size_t)(key0 + row0) * kstride + kc * 8);
  R.k1 = ldg16(kbase + (size_t)(key0 + row1) * kstride + kc * 8);
  if (withV) { R.v0 = ldg16(vtbase + (size_t)row0 * vtstride + key0 + kc * 8); R.v1 = ldg16(vtbase + (size_t)row1 * vtstride + key0 + kc * 8); }
}
DI void kv64_commit(const KVR& R, bf16_t* sK, bf16_t* sVt, bool withV, int tid) {
  const int row0 = tid >> 3, kc = tid & 7, row1 = row0 + 32;
  __syncthreads();
  *(u32x4*)(sK + row0 * 72 + kc * 8) = R.k0;
  *(u32x4*)(sK + row1 * 72 + kc * 8) = R.k1;
  if (withV) { *(u32x4*)(sVt + row0 * 72 + kc * 8) = R.v0; *(u32x4*)(sVt + row1 * 72 + kc * 8) = R.v1; }
  __syncthreads();
}
DI void kv64_store(const KVR& R, bf16_t* sK, bf16_t* sVt, int tid) {
  const int row0 = tid >> 3, kc = tid & 7, row1 = row0 + 32;
  *(u32x4*)(sK + row0 * 72 + kc * 8) = R.k0;
  *(u32x4*)(sK + row1 * 72 + kc * 8) = R.k1;
  *(u32x4*)(sVt + row0 * 72 + kc * 8) = R.v0;
  *(u32x4*)(sVt + row1 * 72 + kc * 8) = R.v1;
}
DI void kv96_store(const KVR& R, bf16_t* sK, bf16_t* sVt, int tid) {
  const int row0 = tid >> 3, kc = tid & 7, row1 = row0 + 32;
  const int rr = tid >> 2, rc = tid & 3;
  *(u32x4*)(sK + row0 * 104 + kc * 8) = R.k0;
  *(u32x4*)(sK + row1 * 104 + kc * 8) = R.k1;
  *(u32x4*)(sK + rr * 104 + 64 + rc * 8) = R.k2;
  *(u32x4*)(sVt + row0 * 72 + kc * 8) = R.v0;
  *(u32x4*)(sVt + row1 * 72 + kc * 8) = R.v1;
}
DI void kv96_fetch(KVR& R, const bf16_t* knbase  , const bf16_t* krbase, const bf16_t* vtbase, int key0, int tid) {
  const int row0 = tid >> 3, kc = tid & 7, row1 = row0 + 32;
  const int rr = tid >> 2, rc = tid & 3;
  R.k0 = ldg16(knbase + (size_t)(key0 + row0) * 1024 + kc * 8);
  R.k1 = ldg16(knbase + (size_t)(key0 + row1) * 1024 + kc * 8);
  R.k2 = ldg16(krbase + (size_t)(key0 + rr) * 32 + rc * 8);
  R.v0 = ldg16(vtbase + (size_t)row0 * SEQ + key0 + kc * 8);
  R.v1 = ldg16(vtbase + (size_t)row1 * SEQ + key0 + kc * 8);
}
DI void kv96_commit(const KVR& R, bf16_t* sK, bf16_t* sVt, int tid) {
  const int row0 = tid >> 3, kc = tid & 7, row1 = row0 + 32;
  const int rr = tid >> 2, rc = tid & 3;
  __syncthreads();
  *(u32x4*)(sK + row0 * 104 + kc * 8) = R.k0;
  *(u32x4*)(sK + row1 * 104 + kc * 8) = R.k1;
  *(u32x4*)(sK + rr * 104 + 64 + rc * 8) = R.k2;
  *(u32x4*)(sVt + row0 * 72 + kc * 8) = R.v0;
  *(u32x4*)(sVt + row1 * 72 + kc * 8) = R.v1;
  __syncthreads();
}

DI void o_zero(f32x16& a, f32x16& b) {
#pragma unroll
  for (int q = 0; q < 16; ++q) { a[q] = 0.f; b[q] = 0.f; }
}

DI int logical_bid() {
  const int G = gridDim.x, bx = blockIdx.x;
  return (G % 8 == 0) ? (bx % 8) * (G / 8) + bx / 8 : bx;
}

DI int colmap(int kind, int n) {
  switch (kind) {
    case 0: return n;
    case 1: return n < 640 ? n : (n < 1664 ? n + 32 : (n < 1696 ? n - 1024 : -1));
    case 2: if (n < 1024) return (n >> 6) * 96 + (n & 63); else { int m = n - 1024; return (m >> 5) * 96 + 64 + (m & 31); }
    case 3: if (n < 1024) return (n >> 6) * 128 + (n & 63); else { int m = n - 1024; return (m >> 6) * 128 + 64 + (m & 63); }
    case 4: return n < 2560 ? n : (n < 3584 ? n + 48 : (n < 3632 ? n - 1024 : -1));
    default: return n < 64 ? n : -1;
  }
}

DI void prep_transpose(const float* W, int K, int Nsrc, int Nd, int kind, const float* kscale, bf16_t* dst, float* tileL, int L, int G) {
  const int tid = otid();
  const int ktiles = K / 64, ntiles = Nd / 64;
  for (int t = L; t < ktiles * ntiles; t += G) {
    const int nt = t / ktiles, kt = t - nt * ktiles;
    const int k0 = kt * 64, n0 = nt * 64;
    const int tx = tid & 63, ty = tid >> 6;
    const int src = colmap(kind, n0 + tx);
    __syncthreads();
    for (int kk = ty; kk < 64; kk += 8) {
      float v = 0.f;
      if (src >= 0) { v = W[(size_t)(k0 + kk) * Nsrc + src]; if (kscale) v *= kscale[k0 + kk]; }
      tileL[kk * 65 + tx] = v;
    }
    __syncthreads();
    const int nl = tid >> 3, kq = tid & 7;
    unsigned pk[4];
#pragma unroll
    for (int e = 0; e < 4; ++e) pk[e] = pack2(tileL[(kq * 8 + 2 * e) * 65 + nl], tileL[(kq * 8 + 2 * e + 1) * 65 + nl]);
    *(uint4*)(dst + (size_t)(n0 + nl) * K + k0 + kq * 8) = make_uint4(pk[0], pk[1], pk[2], pk[3]);
  }
}

DI void phase_prep(const Params& P, unsigned char* smem, int L, int G) {
  unsigned char* ws = P.ws;
  float* tileL = (float*)smem;
  const int tid = otid();
  prep_transpose(P.l0_w_in, 1024, 2560, 2560, 0, nullptr, (bf16_t*)(ws + OFF_WIN0T), tileL, L, G);
  prep_transpose(P.l1_w_in, 1024, 1696, 1792, 1, nullptr, (bf16_t*)(ws + OFF_WIN1T), tileL, L, G);
  prep_transpose(P.l2_w_in, 1024, 3632, 3840, 4, nullptr, (bf16_t*)(ws + OFF_WIN2T), tileL, L, G);
  prep_transpose(P.l3_w_in, 1024, 2560, 2560, 0, nullptr, (bf16_t*)(ws + OFF_WIN3T), tileL, L, G);
  prep_transpose(P.l1_w_uq, 384, 1536, 1536, 2, P.l1_q_norm, (bf16_t*)(ws + OFF_WUQT), tileL, L, G);
  prep_transpose(P.l1_w_ukv, 256, 2048, 2048, 3, P.l1_kv_norm, (bf16_t*)(ws + OFF_WUKVT), tileL, L, G);
  prep_transpose(P.l2_phi_k1, 2048, 256, 256, 0, nullptr, (bf16_t*)(ws + OFF_PK1T), tileL, L, G);
  prep_transpose(P.l2_phi_v1, 2048, 256, 256, 0, nullptr, (bf16_t*)(ws + OFF_PV1T), tileL, L, G);
  prep_transpose(P.l2_phi_k2, 256, 64, 256, 5, nullptr, (bf16_t*)(ws + OFF_PK2T), tileL, L, G);
  prep_transpose(P.l2_phi_v2, 256, 64, 256, 5, nullptr, (bf16_t*)(ws + OFF_PV2T), tileL, L, G);
  for (int i = 0; i < 4; ++i) {
    prep_transpose(P.w_out + (size_t)i * 1024 * 1024, 1024, 1024, 1024, 0, nullptr, (bf16_t*)(ws + OFF_WOUTT) + (size_t)i * 1024 * 1024, tileL, L, G);
    prep_transpose(P.pe_gate + (size_t)i * 1024 * 1024, 1024, 1024, 1024, 0, P.ln_g + i * 1024, (bf16_t*)(ws + OFF_PGT) + (size_t)i * 1024 * 1024, tileL, L, G);
    prep_transpose(P.pe_proj + (size_t)i * 256 * 1024, 256, 1024, 1024, 0, nullptr, (bf16_t*)(ws + OFF_PPT) + (size_t)i * 1024 * 256, tileL, L, G);
  }
  __syncthreads();
  {
    float* red = (float*)smem;
    float* c1 = (float*)(ws + OFF_C1); float* c2 = (float*)(ws + OFF_C2);
    for (int t = L; t < 128; t += G) {
      const int i = t >> 5, n0 = (t & 31) * 32;
      const int kp = tid >> 5, nn = tid & 31;
      const float* W = P.pe_gate + (size_t)i * 1024 * 1024;
      const float* g = P.ln_g + i * 1024; const float* bb = P.ln_b + i * 1024;
      float s1 = 0.f, s2 = 0.f;
      for (int k = kp * 64; k < kp * 64 + 64; ++k) {
        const float wv = W[(size_t)k * 1024 + n0 + nn];
        s1 += bf2f(f2bf(g[k] * wv)); s2 += bb[k] * wv;
      }
      __syncthreads();
      red[kp * 32 + nn] = s1; red[512 + kp * 32 + nn] = s2;
      __syncthreads();
      if (tid < 32) {
        float a = 0.f, b2 = 0.f;
        for (int q = 0; q < 16; ++q) { a += red[q * 32 + tid]; b2 += red[512 + q * 32 + tid]; }
        c1[i * 1024 + n0 + tid] = a; c2[i * 1024 + n0 + tid] = b2;
      }
    }
    __syncthreads();
    float* bias = (float*)(ws + OFF_BIAS);
    for (int t = L; t < 16; t += G) {
      const int which = t >> 3, n0 = (t & 7) * 32;
      const int kp = tid >> 5, nn = tid & 31;
      const float* W = which ? P.l2_phi_v1 : P.l2_phi_k1;
      float s1 = 0.f;
      for (int k = kp * 128; k < kp * 128 + 128; ++k) s1 += P.l2_cmp_pos[k] * W[(size_t)k * 256 + n0 + nn];
      __syncthreads();
      red[kp * 32 + nn] = s1;
      __syncthreads();
      if (tid < 32) { float a = 0.f; for (int q = 0; q < 16; ++q) a += red[q * 32 + tid]; bias[which * 256 + n0 + tid] = a; }
    }
  }
  {
    bf16_t* xbw = (bf16_t*)(ws + OFF_XB); bf16_t* pbw = (bf16_t*)(ws + OFF_PB);
    const size_t nx8 = (size_t)MTOK * 1024 / 8, np8 = (size_t)4 * MTOK * 256 / 8;
    for (size_t idx = (size_t)L * NTHR + tid; idx < nx8 + np8; idx += (size_t)G * NTHR) {
      const bool isx = idx < nx8;
      const size_t e = (isx ? idx : idx - nx8) * 8;
      const float* src = (isx ? P.x : P.p) + e;
      const f32x4 f0 = ldgf4(src), f1 = ldgf4(src + 4);
      *(u32x4*)((isx ? xbw : pbw) + e) = cvt8(f0, f1);
    }
  }
  {
    float2* cs64 = (float2*)(ws + OFF_CS64); float2* cs32 = (float2*)(ws + OFF_CS32);
    const size_t total = (size_t)MTOK * 48;
    for (size_t idx = (size_t)L * NTHR + tid; idx < total; idx += (size_t)G * NTHR) {
      const int tok = (int)(idx / 48), e = (int)(idx - (size_t)tok * 48);
      const float posf = (float)P.pos[tok];
      float sn, cn;
      if (e < 32) { const float inv = powf(10000.f, -(float)e / 32.f); sincosf(posf * inv, &sn, &cn); cs64[(size_t)tok * 32 + e] = make_float2(cn, sn); }
      else { const int e2 = e - 32; const float inv = powf(10000.f, -(float)e2 / 16.f); sincosf(posf * inv, &sn, &cn); cs32[(size_t)tok * 16 + e2] = make_float2(cn, sn); }
    }
  }
}

DI Seg seg_for(int mixer, int nt, bf16_t* big, float* mstat) {
  Seg s; s.kind = K_PLAIN; s.dst = big; s.ld = 1024; s.cbase = 0; s.G = 4; s.nvalid = 1 << 30; s.stat = nullptr; s.statbase = 0; s.bias = nullptr;
  if (mixer == 0) {
    if (nt < 8) { s.kind = K_ROPE64; s.dst = big + SW_Q; s.ld = 1024; s.cbase = 0; }
    else if (nt < 10) { s.kind = K_ROPE64; s.dst = big + SW_K; s.ld = 256; s.cbase = 1024; }
    else if (nt < 12) { s.kind = K_VT; s.dst = big + SW_VT; s.cbase = 1280; s.G = 4; }
    else { s.kind = K_PLAIN; s.dst = big + SW_Z; s.ld = 1024; s.cbase = 1536; }
  } else if (mixer == 1) {
    if (nt < 3) { s.dst = big + ML_CQ; s.ld = 384; s.cbase = 0; s.stat = mstat; s.statbase = 0; }
    else if (nt < 5) { s.dst = big + ML_CKV; s.ld = 256; s.cbase = 384; s.stat = mstat; s.statbase = 6; }
    else if (nt < 13) { s.dst = big + ML_Z; s.ld = 1024; s.cbase = 640; }
    else { s.kind = K_ROPE32; s.dst = big + ML_KR; s.ld = 32; s.cbase = 1664; s.nvalid = 32; }
  } else if (mixer == 2) {
    if (nt < 8) { s.kind = K_ROPE64; s.dst = big + NS_Q; s.ld = 1024; s.cbase = 0; }
    else if (nt < 10) { s.dst = big + NS_KCR; s.ld = 256; s.cbase = 1024; }
    else if (nt < 12) { s.dst = big + NS_VCR; s.ld = 256; s.cbase = 1280; }
    else if (nt < 14) { s.kind = K_ROPE64; s.dst = big + NS_KS; s.ld = 256; s.cbase = 1536; }
    else if (nt < 16) { s.kind = K_VT; s.dst = big + NS_VST; s.cbase = 1792; }
    else if (nt < 18) { s.kind = K_ROPE64; s.dst = big + NS_KW; s.ld = 256; s.cbase = 2048; }
    else if (nt < 20) { s.kind = K_VT; s.dst = big + NS_VWT; s.cbase = 2304; }
    else if (nt < 28) { s.dst = big + NS_Z; s.ld = 1024; s.cbase = 2560; }
    else if (nt == 28) { s.dst = big + NS_GL; s.ld = 64; s.cbase = 3584; s.nvalid = 64; }
    else s.kind = K_NONE;
  } else if (mixer == 3) {
    if (nt < 8) { s.dst = big + ML_QN; s.ld = 1024; s.cbase = 0; }
    else { s.kind = K_ROPE32; s.dst = big + ML_QR; s.ld = 512; s.cbase = 1024; }
  } else if (mixer == 4) {
    if (nt < 8) { s.dst = big + ML_KN; s.ld = 1024; s.cbase = 0; }
    else { s.kind = K_VT; s.dst = big + ML_VT; s.cbase = 1024; s.G = 16; }
  } else if (mixer == 5) {
    s.dst = big + BG_PP; s.ld = 1024; s.cbase = 0;
  }
  return s;
}

DI void panel_tile(int t, int ntn, int pw, int& mt, int& nt) {
  const int per_panel = 256 * pw;
  const int p = t / per_panel;
  const int n0 = p * pw;
  const int w = (ntn - n0) < pw ? (ntn - n0) : pw;
  const int tt = t - p * per_panel;
  mt = tt / w; nt = n0 + (tt - mt * w);
}

template <bool AF32>
DI void phase_inproj_impl(const void* A, int lda, int nk, const bf16_t* Bt, int ntn, int mixer, const Params& P, unsigned char* smem, int L, int G) {
  bf16_t* big = (bf16_t*)(P.ws + OFF_BIG);
  float* mstat = (float*)(P.ws + OFF_MSTAT);
  const float2* cs64 = (const float2*)(P.ws + OFF_CS64);
  const float2* cs32 = (const float2*)(P.ws + OFF_CS32);
  const int ntiles = 256 * ntn;
  const int ldb = nk * 64;
  GR R;
  ARowPlain arb{(const bf16_t*)A, lda};
  const int pw = ntn > 5 ? 5 : ntn;
  if (L < ntiles) { int mt, nt; panel_tile(L, ntn, pw, mt, nt); gemm_first<false>(R, arb, Bt, ldb, mt * 256, nt * 256); }
  for (int t = L; t < ntiles; t += G) {
    int mt, nt; panel_tile(t, ntn, pw, mt, nt);
    f32x16 acc[4][2]; acc_zero(acc);
    const Seg sg0 = seg_for(mixer, nt * 2, big, mstat), sg1 = seg_for(mixer, nt * 2 + 1, big, mstat);
    const bool swp = seg_swapped(sg0.kind);
    gemm_loop<false>(acc, R, arb, Bt, ldb, mt * 256, nt * 256, nk, (bf16_t*)smem, swp);
    if (t + G < ntiles) { int mt2, nt2; panel_tile(t + G, ntn, pw, mt2, nt2); gemm_first<false>(R, arb, Bt, ldb, mt2 * 256, nt2 * 256); }
    __builtin_amdgcn_sched_barrier(0);
    epi_seg(acc, sg0, sg1, mt * 256, nt * 256, nullptr, cs64, cs32, (bf16_t*)smem);
  }
}

DI void phase_mla_up(const Params& P, unsigned char* smem, int L, int G) {
  bf16_t* big = (bf16_t*)(P.ws + OFF_BIG);
  const float* mstat = (const float*)(P.ws + OFF_MSTAT);
  const float2* cs64 = (const float2*)(P.ws + OFF_CS64);
  const float2* cs32 = (const float2*)(P.ws + OFF_CS32);
  float* rowA = (float*)(smem + LDS_ROW_OFF);
  const int nq = 256 * 6, nkv = 256 * 8;
  for (int t = L; t < nq + nkv; t += G) {
    const int tid = otid();
    const bool isq = t < nq;
    const int tt = isq ? t : t - nq;
    const int ntn = isq ? 6 : 8;
    const int mt = tt / ntn, nt = tt - mt * ntn;
    if (tid < 256) {
      const float* ms = mstat + (size_t)(mt * 256 + tid) * 16;
      float ssum;
      if (isq) ssum = (ms[0] + ms[1] + ms[2] + ms[3] + ms[4] + ms[5]) * (1.f / 384.f);
      else ssum = (ms[6] + ms[7] + ms[8] + ms[9]) * (1.f / 256.f);
      rowA[tid] = rsqrtf(ssum + 1e-6f);
    }
    f32x16 acc[4][2]; acc_zero(acc);
    const Seg sg0 = seg_for(isq ? 3 : 4, nt * 2, big, nullptr), sg1 = seg_for(isq ? 3 : 4, nt * 2 + 1, big, nullptr);
    const bool swp = seg_swapped(sg0.kind);
    GR R;
    if (isq) { ARowPlain ar{big + ML_CQ, 384}; gemm_first<false>(R, ar, (const bf16_t*)(P.ws + OFF_WUQT), 384, mt * 256, nt * 256); gemm_loop<false>(acc, R, ar, (const bf16_t*)(P.ws + OFF_WUQT), 384, mt * 256, nt * 256, 6, (bf16_t*)smem, swp); }
    else { ARowPlain ar{big + ML_CKV, 256}; gemm_first<false>(R, ar, (const bf16_t*)(P.ws + OFF_WUKVT), 256, mt * 256, nt * 256); gemm_loop<false>(acc, R, ar, (const bf16_t*)(P.ws + OFF_WUKVT), 256, mt * 256, nt * 256, 4, (bf16_t*)smem, swp); }
    epi_seg(acc, sg0, sg1, mt * 256, nt * 256, rowA, cs64, cs32, (bf16_t*)smem);
  }
}

DI void phase_cmp1(const Params& P, unsigned char* smem, int L, int G) {
  bf16_t* big = (bf16_t*)(P.ws + OFF_BIG);
  const float* bias = (const float*)(P.ws + OFF_BIAS);
  for (int t = L; t < 128; t += G) {
    const int which = t >> 6, mt = t & 63;
    f32x16 acc[4][2]; acc_zero(acc);
    ARowCmp ar{big + (which ? NS_VCR : NS_KCR)};
    GR R; gemm_first<false>(R, ar, (const bf16_t*)(P.ws + (which ? OFF_PV1T : OFF_PK1T)), 2048, mt * 256, 0);
    gemm_loop<false>(acc, R, ar, (const bf16_t*)(P.ws + (which ? OFF_PV1T : OFF_PK1T)), 2048, mt * 256, 0, 32, (bf16_t*)smem, true);
    Seg s; s.kind = K_SILU; s.dst = big + (which ? NS_HV : NS_HK); s.ld = 256; s.cbase = 0; s.G = 4; s.nvalid = 1 << 30; s.stat = nullptr; s.statbase = 0;
    s.bias = bias + which * 256;
    epi_seg(acc, s, s, mt * 256, 0, nullptr, nullptr, nullptr, (bf16_t*)smem);
  }
}
DI void phase_cmp2(const Params& P, unsigned char* smem, int L, int G) {
  bf16_t* big = (bf16_t*)(P.ws + OFF_BIG);
  const float2* cs64 = (const float2*)(P.ws + OFF_CS64);
  for (int t = L; t < 128; t += G) {
    const int which = t >> 6, mt = t & 63;
    f32x16 acc[4][2]; acc_zero(acc);
    ARowPlain ar{big + (which ? NS_HV : NS_HK), 256};
    GR R; gemm_first<false>(R, ar, (const bf16_t*)(P.ws + (which ? OFF_PV2T : OFF_PK2T)), 256, mt * 256, 0);
    gemm_loop<false>(acc, R, ar, (const bf16_t*)(P.ws + (which ? OFF_PV2T : OFF_PK2T)), 256, mt * 256, 0, 4, (bf16_t*)smem, !which);
    Seg s; s.kind = which ? K_VCT : K_KC2; s.dst = big + (which ? NS_VCT : NS_KC2); s.ld = 64; s.cbase = 0; s.G = 4; s.nvalid = 64; s.stat = nullptr; s.statbase = 0; s.bias = nullptr;
    Seg none = s; none.kind = K_NONE;
    epi_seg(acc, s, none, mt * 256, 0, nullptr, cs64, nullptr, (bf16_t*)smem);
  }
}

DI void attn_write_staged(const f32x16& o0, const f32x16& o1, bf16_t* og, const bf16_t* z, size_t tok0, int head, int lane, bf16_t* wl) {
  const int q = lane & 31, h = lane >> 5;
#pragma unroll
  for (int dt = 0; dt < 2; ++dt)
#pragma unroll
    for (int q4 = 0; q4 < 4; ++q4) {
      const f32x16& o = dt ? o1 : o0;
      *(uint2*)(wl + q * 72 + dt * 32 + 8 * q4 + 4 * h) = make_uint2(pack2(o[4 * q4], o[4 * q4 + 1]), pack2(o[4 * q4 + 2], o[4 * q4 + 3]));
    }
#pragma unroll
  for (int k = 0; k < 4; ++k) {
    const int ci = lane + 64 * k, row = ci >> 3, c8 = ci & 7;
    const u32x4 ov = *(const u32x4*)(wl + row * 72 + c8 * 8);
    const size_t off = (tok0 + row) * 1024 + head * 64 + c8 * 8;
    const u32x4 zv = ldg16(z + off);
    u32x4 r;
    r.x = pack2(bflo(ov.x) * siluf_(bflo(zv.x)), bfhi(ov.x) * siluf_(bfhi(zv.x)));
    r.y = pack2(bflo(ov.y) * siluf_(bflo(zv.y)), bfhi(ov.y) * siluf_(bfhi(zv.y)));
    r.z = pack2(bflo(ov.z) * siluf_(bflo(zv.z)), bfhi(ov.z) * siluf_(bfhi(zv.z)));
    r.w = pack2(bflo(ov.w) * siluf_(bflo(zv.w)), bfhi(ov.w) * siluf_(bfhi(zv.w)));
    *(u32x4*)(og + off) = r;
  }
}
DI void attn_write(const f32x16& o0, const f32x16& o1, bf16_t* og, const bf16_t* z, size_t tok, int head, int h) {
#pragma unroll
  for (int dt = 0; dt < 2; ++dt)
#pragma unroll
    for (int q4 = 0; q4 < 4; ++q4) {
      const int d = dt * 32 + 8 * q4 + 4 * h;
      const size_t off = tok * 1024 + head * 64 + d;
      const uint2 zz = *(const uint2*)(z + off);
      const f32x16& o = dt ? o1 : o0;
      uint2 pk;
      pk.x = pack2(o[4 * q4] * siluf_(bflo(zz.x)), o[4 * q4 + 1] * siluf_(bfhi(zz.x)));
      pk.y = pack2(o[4 * q4 + 2] * siluf_(bflo(zz.y)), o[4 * q4 + 3] * siluf_(bfhi(zz.y)));
      *(uint2*)(og + off) = pk;
    }
}

DI void gqa_item(int p, int L, int G, int gi, int& qt, int& bg) {
  if (G == 256) { const int x = L >> 5, lb = L & 31, k = p >> 8; bg = x * 16 + (k & ~1) + gi; qt = (k & 1) ? 63 - lb : lb; }
  else { qt = 63 - (p >> 6); bg = (p & 63) * 2 + gi; }
}
DI void mla_item(int p, int L, int G, int gi, int& qt, int& bh) {
  if (G == 256) { const int x = L >> 5, lb = L & 31, k = p >> 8; bh = x * 64 + k * 4 + (lb >> 4) * 2 + gi; qt = (k & 1) ? 15 - (lb & 15) : (lb & 15); }
  else { qt = 15 - (p >> 8); bh = (p & 255) * 2 + gi; }
}

DI void phase_attn_swa(const Params& P, const float* sinks, bf16_t* og, unsigned char* smem, int L, int G) {
  bf16_t* big = (bf16_t*)(P.ws + OFF_BIG);
  const int tid0 = otid(), gi = tid0 >> 8, tid = tid0 & 255, lane = tid & 63, w = tid >> 6, r = lane & 31, h = lane >> 5;
  smem += gi * ATT_LDS;
  bf16_t* sK = (bf16_t*)smem; bf16_t* sVt = sK + 64 * 72;
  const float sc = 0.125f * LOG2E;
  for (int it = L; it < 4096; it += G) {
    int qt, bg; gqa_item(it, L, G, gi, qt, bg);
    const int b = bg >> 2, g = bg & 3;
    const int t0 = qt * 32, t = t0 + r, head = g * 4 + w;
    const size_t tok = (size_t)b * SEQ + t;
    bf16x8 qf[4];
#pragma unroll
    for (int ks = 0; ks < 4; ++ks) qf[ks] = *(const bf16x8*)(big + SW_Q + tok * 1024 + head * 64 + ks * 16 + 8 * h);
    f32x16 o0, o1, s[2]; o_zero(o0, o1);
    float m = sinks[head] * LOG2E, l = 1.f;
    const bf16_t* kb = big + SW_K + (size_t)b * SEQ * 256 + g * 64;
    const bf16_t* vb = big + SW_VT + (size_t)((b * 4 + g) * 64) * SEQ;
    const int jlo = (t0 - 127 > 0 ? t0 - 127 : 0) >> 6, jhi = (t0 + 31) >> 6;
    KVR R; kv64_fetch(R, kb, 256, vb, SEQ, jlo * 64, true, tid);
    __syncthreads();
    kv64_store(R, sK, sVt, tid);
    if (jlo < jhi) kv64_fetch(R, kb, 256, vb, SEQ, jlo * 64 + 64, true, tid);
    for (int j = jlo; j <= jhi; ++j) {
      const int key0 = j * 64, cb = (j - jlo) & 1;
      __syncthreads();
      if (j < jhi) kv64_store(R, sK + (cb ^ 1) * KVB64, sVt + (cb ^ 1) * KVB64, tid);
      if (j + 1 < jhi) kv64_fetch(R, kb, 256, vb, SEQ, key0 + 128, true, tid);
      __builtin_amdgcn_sched_barrier(0);
      auto mf = [&](int kk) { const int key = key0 + kk; return key <= t && key > t - 128; };
      attn_step<64, true, 0>(sK + cb * KVB64, sVt + cb * KVB64, qf, o0, o1, m, l, sc, mf, lane, s, 0.f);
    }
    const float il = 1.f / l;
#pragma unroll
    for (int q = 0; q < 16; ++q) { o0[q] *= il; o1[q] *= il; }
    attn_write_staged(o0, o1, og, big + SW_Z, (size_t)b * SEQ + t0, head, lane, (bf16_t*)(smem + 40960) + w * (32 * 72));
  }
}

struct KVR8 { u32x4 k0, k2, v0; };
DI void kv96x8_fetch(KVR8& R, const bf16_t* knbase, const bf16_t* krbase, const bf16_t* vtbase, int key0, int tid) {
  const int row = tid >> 3, kc = tid & 7, rr = (tid & 255) >> 2, rc = tid & 3;
  R.k0 = ldg16(knbase + (size_t)(key0 + row) * 1024 + kc * 8);
  R.k2 = ldg16(krbase + (size_t)(key0 + rr) * 32 + rc * 8);
  R.v0 = ldg16(vtbase + (size_t)row * SEQ + key0 + kc * 8);
}
DI void kv96x8_store(const KVR8& R, bf16_t* sK, bf16_t* sVt, int tid) {
  const int row = tid >> 3, kc = tid & 7, rr = (tid & 255) >> 2, rc = tid & 3;
  *(u32x4*)(sK + row * 104 + kc * 8) = R.k0;
  if (tid < 256) *(u32x4*)(sK + rr * 104 + 64 + rc * 8) = R.k2;
  *(u32x4*)(sVt + row * 72 + kc * 8) = R.v0;
}
DI void mla_item8(int p, int L, int G, int& qt, int& bh) {
  if (G == 256) { const int x = L >> 5, lb = L & 31, k = p >> 8; bh = x * 64 + k * 4 + (lb >> 3); qt = (k & 1) ? 7 - (lb & 7) : (lb & 7); }
  else { qt = 7 - (p >> 9); bh = p & 511; }
}
DI void phase_attn_mla(const Params& P, bf16_t* og, unsigned char* smem, int L, int G) {
  bf16_t* big = (bf16_t*)(P.ws + OFF_BIG);
  const int tid = otid(), lane = tid & 63, w = tid >> 6, r = lane & 31, h = lane >> 5;
  bf16_t* sK = (bf16_t*)smem; bf16_t* sVt = sK + 64 * 104;
  const float sc = 0.10206207261596575f * LOG2E;
  for (int it = L; it < 4096; it += G) {
    int qt, bh; mla_item8(it, L, G, qt, bh);
    const int b = bh >> 4, head = bh & 15;
    const int t0 = qt * 256 + w * 32, t = t0 + r;
    const size_t tok = (size_t)b * SEQ + t;
    bf16x8 qf[6];
#pragma unroll
    for (int ks = 0; ks < 4; ++ks) qf[ks] = *(const bf16x8*)(big + ML_QN + tok * 1024 + head * 64 + ks * 16 + 8 * h);
#pragma unroll
    for (int ks = 0; ks < 2; ++ks) qf[4 + ks] = *(const bf16x8*)(big + ML_QR + tok * 512 + head * 32 + ks * 16 + 8 * h);
    f32x16 o0, o1, s[2]; o_zero(o0, o1);
    float m = NEGF, l = 0.f;
    const bf16_t* knb = big + ML_KN + (size_t)b * SEQ * 1024 + head * 64;
    const bf16_t* krb = big + ML_KR + (size_t)b * SEQ * 32;
    const bf16_t* vb = big + ML_VT + (size_t)((b * 16 + head) * 64) * SEQ;
    const int jhi = (qt * 256 + 255) >> 6;
    KVR8 R; kv96x8_fetch(R, knb, krb, vb, 0, tid);
    __syncthreads();
    kv96x8_store(R, sK, sVt, tid);
    if (0 < jhi) kv96x8_fetch(R, knb, krb, vb, 64, tid);
    for (int j = 0; j <= jhi; ++j) {
      const int key0 = j * 64, cb = j & 1;
      __syncthreads();
      if (j < jhi) kv96x8_store(R, sK + (cb ^ 1) * KVB96, sVt + (cb ^ 1) * KVB96, tid);
      if (j + 1 < jhi) kv96x8_fetch(R, knb, krb, vb, key0 + 128, tid);
      __builtin_amdgcn_sched_barrier(0);
      if (key0 <= t0 + 31) {
        auto mf = [&](int kk) { return key0 + kk <= t; };
        if (key0 + 63 > t0) attn_step<96, true, 0>(sK + cb * KVB96, sVt + cb * KVB96, qf, o0, o1, m, l, sc, mf, lane, s, 0.f);
        else attn_step<96, false, 0>(sK + cb * KVB96, sVt + cb * KVB96, qf, o0, o1, m, l, sc, mf, lane, s, 0.f);
      }
    }
    const float il = 1.f / l;
#pragma unroll
    for (int q = 0; q < 16; ++q) { o0[q] *= il; o1[q] *= il; }
    attn_write_staged(o0, o1, og, big + ML_Z, (size_t)b * SEQ + t0, head, lane, (bf16_t*)(smem + 49152) + w * (32 * 72));
  }
}

DI void tot_store(float* totL, int tid, const f32x16& a, const f32x16& b, float gi) {
#pragma unroll
  for (int k = 0; k < 4; ++k) {
    f32x4 v0 = {a[4 * k] * gi, a[4 * k + 1] * gi, a[4 * k + 2] * gi, a[4 * k + 3] * gi};
    f32x4 v1 = {b[4 * k] * gi, b[4 * k + 1] * gi, b[4 * k + 2] * gi, b[4 * k + 3] * gi};
    *(f32x4*)(totL + ((size_t)(k * 256 + tid)) * 4) = v0;
    *(f32x4*)(totL + ((size_t)((4 + k) * 256 + tid)) * 4) = v1;
  }
}
DI void tot_addto(float* totL, int tid, f32x16& a, f32x16& b, float gi) {
#pragma unroll
  for (int k = 0; k < 4; ++k) {
    const f32x4 v0 = *(const f32x4*)(totL + ((size_t)(k * 256 + tid)) * 4);
    const f32x4 v1 = *(const f32x4*)(totL + ((size_t)((4 + k) * 256 + tid)) * 4);
    a[4 * k] = v0.x + gi * a[4 * k]; a[4 * k + 1] = v0.y + gi * a[4 * k + 1]; a[4 * k + 2] = v0.z + gi * a[4 * k + 2]; a[4 * k + 3] = v0.w + gi * a[4 * k + 3];
    b[4 * k] = v1.x + gi * b[4 * k]; b[4 * k + 1] = v1.y + gi * b[4 * k + 1]; b[4 * k + 2] = v1.z + gi * b[4 * k + 2]; b[4 * k + 3] = v1.w + gi * b[4 * k + 3];
  }
}
DI void phase_attn_nsa(const Params& P, bf16_t* og, unsigned char* smem, int L, int G) {
  bf16_t* big = (bf16_t*)(P.ws + OFF_BIG);
  const int gi = otid() >> 8;
  smem += gi * ATT_LDS;
  bf16_t* sK = (bf16_t*)smem; bf16_t* sVt = sK + 64 * 72;
  float* impL = (float*)(smem + 37376);
  float* scoreL = impL + 4 * 32 * 33;
  unsigned* selL = (unsigned*)(smem + 36864);
  float* totL = (float*)(smem + 37376);
  const float sc = 0.125f * LOG2E;
  for (int it = L; it < 4096; it += G) {
    int tid = threadIdx.x;
    asm volatile("" : "+v"(tid));
    tid &= 255;
    const int lane = tid & 63, w = tid >> 6, r = lane & 31, h = lane >> 5;
    int qt, bg; gqa_item(it, L, G, gi, qt, bg);
    const int b = bg >> 2, g = bg & 3;
    const int t0 = qt * 32, t = t0 + r, head = g * 4 + w;
    const size_t tok = (size_t)b * SEQ + t;
    bf16x8 qf[4];
#pragma unroll
    for (int ks = 0; ks < 4; ++ks) qf[ks] = *(const bf16x8*)(big + NS_Q + tok * 1024 + head * 64 + ks * 16 + 8 * h);
    const bf16_t* glp = big + NS_GL + tok * 64;
    const float g0 = sigmoidf_(bf2f(glp[head])), g1 = sigmoidf_(bf2f(glp[16 + head])), g2 = sigmoidf_(bf2f(glp[32 + head]));
    f32x16 o0, o1, s[2];
    {
      const bf16_t* kb = big + NS_KC2 + (size_t)((b * 4 + g) * 128) * 64;
      const bf16_t* vb = big + NS_VCT + (size_t)((b * 4 + g) * 64) * 128;
      float m = NEGF, l = 0.f;
      KVR R; kv64_fetch(R, kb, 64, vb, 128, 0, false, tid);
#pragma unroll
      for (int tile = 0; tile < 2; ++tile) {
        const int key0 = tile * 64;
        kv64_commit(R, sK, sVt, false, tid);
        if (tile == 0) kv64_fetch(R, kb, 64, vb, 128, 64, false, tid); else kv64_fetch(R, kb, 64, vb, 128, 0, true, tid);
        __builtin_amdgcn_sched_barrier(0);
        auto mf = [&](int kk) { return (key0 + kk) * 16 + 31 <= t; };
        attn_step<64, true, 1>(sK, sVt, qf, o0, o1, m, l, sc, mf, lane, s, 0.f);
      }
      const float invl = l > 0.f ? 1.f / l : 0.f;
      o_zero(o0, o1);
      float cprev = 0.f;
#pragma unroll
      for (int tile = 0; tile < 2; ++tile) {
        const int key0 = tile * 64;
        kv64_commit(R, sK, sVt, true, tid);
        if (tile == 0) kv64_fetch(R, kb, 64, vb, 128, 64, true, tid);
        __builtin_amdgcn_sched_barrier(0);
        auto mf = [&](int kk) { return (key0 + kk) * 16 + 31 <= t; };
        float l2 = 0.f;
        attn_step<64, true, 2>(sK, sVt, qf, o0, o1, m, l2, sc, mf, lane, s, invl);
#pragma unroll
        for (int sub = 0; sub < 2; ++sub)
#pragma unroll
          for (int s2 = 0; s2 < 2; ++s2) {
            const int Gi = tile * 4 + sub * 2 + s2;
            const int q0 = 8 * s2;
            const float Aj = s[sub][q0] + s[sub][q0 + 1] + s[sub][q0 + 2] + s[sub][q0 + 3];
            const float Bj = s[sub][q0 + 4] + s[sub][q0 + 5] + s[sub][q0 + 6] + s[sub][q0 + 7] + s[sub][q0 + 3];
            const float cx = shx(s[sub][q0 + 7], 32);
            const float add = h ? cx : cprev;
            cprev = cx;
            impL[(w * 32 + r) * 33 + 4 * Gi + 2 * h] = Aj + add;
            impL[(w * 32 + r) * 33 + 4 * Gi + 2 * h + 1] = Bj;
          }
      }
    }
    __syncthreads();
#pragma unroll
    for (int pss = 0; pss < 4; ++pss) {
      const int pair = pss * 256 + tid, q = pair >> 5, j = pair & 31;
      scoreL[q * 33 + j] = impL[(0 * 32 + q) * 33 + j] + impL[(1 * 32 + q) * 33 + j] + impL[(2 * 32 + q) * 33 + j] + impL[(3 * 32 + q) * 33 + j];
    }
    __syncthreads();
#pragma unroll
    for (int pss = 0; pss < 4; ++pss) {
      const int pair = pss * 256 + tid, q = pair >> 5, j = pair & 31;
      const int tq = t0 + q, cur = tq >> 6;
      const bool forced = (j == 0) || (j == cur) || (j == cur - 1);
      const int nf = cur >= 2 ? 3 : cur + 1;
      const int need = 8 - nf;
      const bool cand = (j >= 1) && (j <= cur - 2);
      const float sj = scoreL[q * 33 + j];
      int rank = 0;
      for (int j2 = 1; j2 <= cur - 2; ++j2) {
        const float s2v = scoreL[q * 33 + j2];
        rank += (s2v > sj || (s2v == sj && j2 < j)) ? 1 : 0;
      }
      const bool selected = forced || (cand && rank < need);
      const unsigned long long bal = __ballot(selected);
      if (j == 0) selL[q] = (unsigned)(bal >> (32 * (lane >> 5)));
    }
    __syncthreads();
    const unsigned sel = selL[r];
    unsigned selU = sel;
    selU |= (unsigned)__shfl_xor((int)selU, 1, 64); selU |= (unsigned)__shfl_xor((int)selU, 2, 64); selU |= (unsigned)__shfl_xor((int)selU, 4, 64);
    selU |= (unsigned)__shfl_xor((int)selU, 8, 64); selU |= (unsigned)__shfl_xor((int)selU, 16, 64);
    selU = (unsigned)__builtin_amdgcn_readfirstlane((int)selU);
    tot_store(totL, tid, o0, o1, g0);
    {
      const bf16_t* kb = big + NS_KS + (size_t)b * SEQ * 256 + g * 64;
      const bf16_t* vb = big + NS_VST + (size_t)((b * 4 + g) * 64) * SEQ;
      float m = NEGF, l = 0.f; o_zero(o0, o1);
      const int jhi = (t0 + 31) >> 6;
      KVR R; kv64_fetch(R, kb, 256, vb, SEQ, 0, true, tid);
      __syncthreads();
      kv64_store(R, sK, sVt, tid);
      if (0 < jhi) kv64_fetch(R, kb, 256, vb, SEQ, 64, true, tid);
      for (int j = 0; j <= jhi; ++j) {
        const int key0 = j * 64, cb = j & 1;
        __syncthreads();
        if (j < jhi) kv64_store(R, sK + (cb ^ 1) * KVB64, sVt + (cb ^ 1) * KVB64, tid);
        if (j + 1 < jhi) kv64_fetch(R, kb, 256, vb, SEQ, key0 + 128, true, tid);
        __builtin_amdgcn_sched_barrier(0);
        if ((selU >> j) & 1u) {
          const bool lsel = (sel >> j) & 1u;
          auto mf = [&](int kk) { return lsel && (key0 + kk <= t); };
          if (key0 + 63 > t0) attn_step<64, true, 0>(sK + cb * KVB64, sVt + cb * KVB64, qf, o0, o1, m, l, sc, mf, lane, s, 0.f);
          else attn_step<64, false, 0>(sK + cb * KVB64, sVt + cb * KVB64, qf, o0, o1, m, l, sc, mf, lane, s, 0.f, lsel);
        }
      }
      tot_addto(totL, tid, o0, o1, g1 / l);
      tot_store(totL, tid, o0, o1, 1.f);
    }
    {
      const bf16_t* kb = big + NS_KW + (size_t)b * SEQ * 256 + g * 64;
      const bf16_t* vb = big + NS_VWT + (size_t)((b * 4 + g) * 64) * SEQ;
      float m = NEGF, l = 0.f; o_zero(o0, o1);
      const int jlo = (t0 - 511 > 0 ? t0 - 511 : 0) >> 6, jhi = (t0 + 31) >> 6;
      KVR R; kv64_fetch(R, kb, 256, vb, SEQ, jlo * 64, true, tid);
      __syncthreads();
      kv64_store(R, sK, sVt, tid);
      if (jlo < jhi) kv64_fetch(R, kb, 256, vb, SEQ, jlo * 64 + 64, true, tid);
      for (int j = jlo; j <= jhi; ++j) {
        const int key0 = j * 64, cb = (j - jlo) & 1;
        __syncthreads();
        if (j < jhi) kv64_store(R, sK + (cb ^ 1) * KVB64, sVt + (cb ^ 1) * KVB64, tid);
        if (j + 1 < jhi) kv64_fetch(R, kb, 256, vb, SEQ, key0 + 128, true, tid);
        __builtin_amdgcn_sched_barrier(0);
        auto mf = [&](int kk) { const int key = key0 + kk; return key <= t && key > t - 512; };
        if (key0 + 63 > t0 || key0 <= t0 + 31 - 512) attn_step<64, true, 0>(sK + cb * KVB64, sVt + cb * KVB64, qf, o0, o1, m, l, sc, mf, lane, s, 0.f);
        else attn_step<64, false, 0>(sK + cb * KVB64, sVt + cb * KVB64, qf, o0, o1, m, l, sc, mf, lane, s, 0.f);
      }
      tot_addto(totL, tid, o0, o1, g2 / l);
    }
    __syncthreads();
    attn_write_staged(o0, o1, og, big + NS_Z, (size_t)b * SEQ + t0, head, lane, sK + w * (32 * 72));
    __syncthreads();
  }
}

template <bool XF32>
DI void phase_outproj(const Params& P, int layer, const void* xres, const bf16_t* og, unsigned char* smem, int L, int G) {
  bf16_t* Sb = (bf16_t*)(P.ws + OFF_BIG);
  float* stats = (float*)(P.ws + OFF_STATS);
  const bf16_t* Bt = (const bf16_t*)(P.ws + OFF_WOUTT) + (size_t)layer * 1024 * 1024;
  bf16_t* stg = (bf16_t*)smem;
  GR R;
  ARowPlain ar{og, 1024};
  if (L < 256 * 4) gemm_first<false>(R, ar, Bt, 1024, (L >> 2) * 256, (L & 3) * 256);
  for (int t = L; t < 256 * 4; t += G) {
    const int mt = t >> 2, nt = t & 3;
    const int tid = otid();
    const int lane = tid & 63, w = tid >> 6, r = lane & 31, h = lane >> 5;
    const int wm = w >> 2, wn = w & 3;
    f32x16 acc[4][2]; acc_zero(acc);
    gemm_loop<false>(acc, R, ar, Bt, 1024, mt * 256, nt * 256, 16, (bf16_t*)smem, true);
    if (t + G < 256 * 4) gemm_first<false>(R, ar, Bt, 1024, ((t + G) >> 2) * 256, ((t + G) & 3) * 256);
    __builtin_amdgcn_sched_barrier(0);
    stage_load_tile<true>(stg, (const bf16_t*)xres + (size_t)mt * 256 * 1024 + nt * 256);
    __syncthreads();
#pragma unroll
    for (int j = 0; j < 2; ++j)
#pragma unroll
      for (int ch = 0; ch < 2; ++ch) {
        float s1 = 0.f, s2 = 0.f;
#pragma unroll
        for (int i = 2 * ch; i < 2 * ch + 2; ++i)
#pragma unroll
          for (int q4 = 0; q4 < 4; ++q4) {
            uint2* pp = (uint2*)(stg + (wn * 64 + j * 32 + r) * STG + wm * 128 + i * 32 + 8 * q4 + 4 * h);
            const uint2 xv = *pp;
            uint2 pk;
            pk.x = pack2(DN_ALPHA * bflo(xv.x) + acc[i][j][4 * q4], DN_ALPHA * bfhi(xv.x) + acc[i][j][4 * q4 + 1]);
            pk.y = pack2(DN_ALPHA * bflo(xv.y) + acc[i][j][4 * q4 + 2], DN_ALPHA * bfhi(xv.y) + acc[i][j][4 * q4 + 3]);
            *pp = pk;
            const float f0 = bflo(pk.x), f1 = bfhi(pk.x), f2 = bflo(pk.y), f3 = bfhi(pk.y);
            s1 += (f0 + f1) + (f2 + f3); s2 += (f0 * f0 + f1 * f1) + (f2 * f2 + f3 * f3);
            __builtin_amdgcn_sched_barrier(0);
          }
        s1 += shx(s1, 32); s2 += shx(s2, 32);
        if (h == 0) {
          const size_t row = (size_t)(mt * 256 + wn * 64 + j * 32 + r);
          *(float2*)(stats + row * 32 + (nt * 4 + wm * 2 + ch) * 2) = make_float2(s1, s2);
        }
      }
    __syncthreads();
    stage_store_tile(stg, Sb + (size_t)mt * 256 * 1024 + nt * 256);
    __syncthreads();
  }
}

template <bool LAST>
DI void phase_gate(const Params& P, int layer, unsigned char* smem, int L, int G) {
  const bf16_t* Sb = (const bf16_t*)(P.ws + OFF_BIG);
  const bf16_t* PPb = (const bf16_t*)(P.ws + OFF_BIG) + BG_PP;
  const float* stats = (const float*)(P.ws + OFF_STATS);
  const bf16_t* Bg = (const bf16_t*)(P.ws + OFF_PGT) + (size_t)layer * 1024 * 1024;
  const float* c1 = (const float*)(P.ws + OFF_C1) + layer * 1024;
  const float* c2 = (const float*)(P.ws + OFF_C2) + layer * 1024;
  const float* lg = P.ln_g + layer * 1024; const float* lb = P.ln_b + layer * 1024;
  bf16_t* xb = (bf16_t*)(P.ws + OFF_XB);
  float* rowA = (float*)(smem + LDS_ROW_OFF); float* rowB = rowA + 256;
  float* vecL = (float*)(smem + LDS_VEC_OFF);
  bf16_t* stg = (bf16_t*)smem;
  GR R;
  ARowPlain ars{Sb, 1024};
  for (int t = L; t < 256 * 4; t += G) {
    const int mt = t >> 2, nt = t & 3;
    const int tid = otid();
    const int lane = tid & 63, w = tid >> 6, r = lane & 31, h = lane >> 5;
    const int wm = w >> 2, wn = w & 3;
    if (tid < 256) {
      const f32x4* st = (const f32x4*)(stats + (size_t)(mt * 256 + tid) * 32);
      float a = 0.f, b2 = 0.f;
#pragma unroll
      for (int q = 0; q < 8; ++q) { const f32x4 v = st[q]; a += v.x + v.z; b2 += v.y + v.w; }
      const float mu = a * (1.f / 1024.f);
      const float var = b2 * (1.f / 1024.f) - mu * mu;
      rowA[tid] = mu; rowB[tid] = rsqrtf(fmaxf(var, 0.f) + 1e-5f);
      vecL[tid] = c1[nt * 256 + tid]; vecL[256 + tid] = c2[nt * 256 + tid]; vecL[512 + tid] = lg[nt * 256 + tid]; vecL[768 + tid] = lb[nt * 256 + tid];
    }
    f32x16 accu[4][2]; acc_zero(accu);
    if (t == L) gemm_first<false>(R, ars, Bg, 1024, mt * 256, nt * 256);
    gemm_loop<false>(accu, R, ars, Bg, 1024, mt * 256, nt * 256, 16, (bf16_t*)smem, true);
    if (t + G < 256 * 4) gemm_first<false>(R, ars, Bg, 1024, ((t + G) >> 2) * 256, ((t + G) & 3) * 256);
    __builtin_amdgcn_sched_barrier(0);
    unsigned gq[4][2][8];
#pragma unroll
    for (int i = 0; i < 4; ++i)
#pragma unroll
      for (int q4 = 0; q4 < 4; ++q4) {
        const int fl = wm * 128 + i * 32 + 8 * q4 + 4 * h;
        const f32x4 c1v = *(const f32x4*)(vecL + fl), c2v = *(const f32x4*)(vecL + 256 + fl);
        const float c1a[4] = {c1v.x, c1v.y, c1v.z, c1v.w}, c2a[4] = {c2v.x, c2v.y, c2v.z, c2v.w};
#pragma unroll
        for (int j = 0; j < 2; ++j) {
          const int lrow = wn * 64 + j * 32 + r;
          const float mu = rowA[lrow], rstd = rowB[lrow];
          float sg4[4];
#pragma unroll
          for (int e = 0; e < 4; ++e) sg4[e] = sigmoidf_(rstd * (accu[i][j][4 * q4 + e] - mu * c1a[e]) + c2a[e]);
          gq[i][j][2 * q4] = pack2(sg4[0], sg4[1]); gq[i][j][2 * q4 + 1] = pack2(sg4[2], sg4[3]);
        }
        __builtin_amdgcn_sched_barrier(0);
      }
    stage_load_tile<true>(stg, PPb + (size_t)mt * 256 * 1024 + nt * 256);
    __syncthreads();
    {
      const int tid1 = otid();
      const int lane1 = tid1 & 63, w1 = tid1 >> 6, r1 = lane1 & 31, h1 = lane1 >> 5, wm1 = w1 >> 2, wn1 = w1 & 3;
#pragma unroll
      for (int i = 0; i < 4; ++i)
#pragma unroll
        for (int q4 = 0; q4 < 4; ++q4) {
#pragma unroll
          for (int j = 0; j < 2; ++j) {
            const uint2 pv = *(const uint2*)(stg + (wn1 * 64 + j * 32 + r1) * STG + wm1 * 128 + i * 32 + 8 * q4 + 4 * h1);
            const unsigned g0 = gq[i][j][2 * q4], g1 = gq[i][j][2 * q4 + 1];
            gq[i][j][2 * q4] = pack2(bflo(g0) * bflo(pv.x), bfhi(g0) * bfhi(pv.x));
            gq[i][j][2 * q4 + 1] = pack2(bflo(g1) * bflo(pv.y), bfhi(g1) * bfhi(pv.y));
          }
          __builtin_amdgcn_sched_barrier(0);
        }
    }
    __syncthreads();
    stage_load_tile<false>(stg, Sb + (size_t)mt * 256 * 1024 + nt * 256);
    __syncthreads();
    const int tid2 = otid();
    const int lane2 = tid2 & 63, w2 = tid2 >> 6, r2 = lane2 & 31, h2 = lane2 >> 5, wm2 = w2 >> 2, wn2 = w2 & 3;
#pragma unroll
    for (int i = 0; i < 4; ++i)
#pragma unroll
      for (int q4 = 0; q4 < 4; ++q4) {
        const int fl = wm2 * 128 + i * 32 + 8 * q4 + 4 * h2;
        const int f0 = nt * 256 + fl;
        const f32x4 gv = *(const f32x4*)(vecL + 512 + fl), bv = *(const f32x4*)(vecL + 768 + fl);
        const float ga[4] = {gv.x, gv.y, gv.z, gv.w}, ba[4] = {bv.x, bv.y, bv.z, bv.w};
#pragma unroll
        for (int j = 0; j < 2; ++j) {
          const int lrow = wn2 * 64 + j * 32 + r2;
          const float mu = rowA[lrow], rstd = rowB[lrow];
          uint2* sp = (uint2*)(stg + lrow * STG + fl);
          const uint2 sv = *sp;
          const float sa[4] = {bflo(sv.x), bfhi(sv.x), bflo(sv.y), bfhi(sv.y)};
          float y[4];
          const float gg[4] = {bflo(gq[i][j][2 * q4]), bfhi(gq[i][j][2 * q4]), bflo(gq[i][j][2 * q4 + 1]), bfhi(gq[i][j][2 * q4 + 1])};
#pragma unroll
          for (int e = 0; e < 4; ++e) y[e] = (sa[e] - mu) * rstd * ga[e] + ba[e] + gg[e];
          if (LAST) { f32x4 o = {y[0], y[1], y[2], y[3]}; *(f32x4*)(P.out + (size_t)(mt * 256 + lrow) * 1024 + f0) = o; }
          else { uint2 pk; pk.x = pack2(y[0], y[1]); pk.y = pack2(y[2], y[3]); *sp = pk; }
        }
        __builtin_amdgcn_sched_barrier(0);
      }
    __syncthreads();
    if (!LAST) stage_store_tile(stg, xb + (size_t)mt * 256 * 1024 + nt * 256);
    __syncthreads();
  }
}

#define XB_TMO      128
#define XB_XCNT(j)  (256  + 64 * (j))
#define XB_XSUB(j)  (1280 + 64 * (j))
#define XB_XGEN(j)  (2304 + 64 * (j))
#define XB_TOP      3328
#define XB_TOPGEN   3392
#define XCD_BAR_WORDS 3456
#define XB_SPIN_CAP (1u << 22)
#define LAS __attribute__((address_space(3)))
DI unsigned xb_ld(unsigned* p) { return __hip_atomic_load(p, __ATOMIC_RELAXED, __HIP_MEMORY_SCOPE_AGENT); }
DI unsigned xb_add(unsigned* p, unsigned v) { return __hip_atomic_fetch_add(p, v, __ATOMIC_RELAXED, __HIP_MEMORY_SCOPE_AGENT); }
DI unsigned xb_xcc_id() { return (unsigned)__builtin_amdgcn_s_getreg((3 << 11) | 20) & 0xFu; }
#define XB_SPIN(cond, bar) do { unsigned _sp = 0; while (cond) { __builtin_amdgcn_s_sleep(1); \
    if ((++_sp & 255u) == 0u) { if (xb_ld(&(bar)[XB_TMO])) break; if (_sp > XB_SPIN_CAP) { atomicAdd(&(bar)[XB_TMO], 1u); break; } } } } while (0)
struct XcdBarrier { unsigned* bar; unsigned x; volatile LAS unsigned* st; };
DI XcdBarrier xcd_barrier_post(unsigned* bar, volatile LAS unsigned* st) {
  XcdBarrier b; b.bar = bar; b.x = xb_xcc_id(); b.st = st;
  if (threadIdx.x == 0) (void)xb_add(&bar[XB_XCNT(b.x)], 1u);
  return b;
}
DI void xcd_barrier_complete(unsigned* bar, unsigned x, unsigned& nloc, unsigned& nx) {
  const unsigned G = gridDim.x * gridDim.y * gridDim.z;
  unsigned sum, cnt, mine, sp = 0u;
  for (;;) {
    sum = 0u; cnt = 0u; mine = 0u;
#pragma unroll
    for (unsigned j = 0; j < 16; ++j) { const unsigned c = xb_ld(&bar[XB_XCNT(j)]); sum += c; cnt += (c > 0u) ? 1u : 0u; mine = (j == x) ? c : mine; }
    if (sum == G) break;
    __builtin_amdgcn_s_sleep(1);
    if ((++sp & 255u) == 0u) { if (xb_ld(&bar[XB_TMO])) break; if (sp > XB_SPIN_CAP) { atomicAdd(&bar[XB_TMO], 1u); break; } }
  }
  nloc = mine > 0u ? mine : 1u; nx = cnt > 0u ? cnt : 1u;
}
DI void xcd_barrier(const XcdBarrier& b) {
  asm volatile("s_waitcnt vmcnt(0)" ::: "memory");
  __syncthreads();
  if (threadIdx.x == 0) {
    unsigned* bar = b.bar;
    __builtin_amdgcn_s_waitcnt(0);
    unsigned nloc = b.st[0], nx = b.st[1];
    if (nloc == 0u) { xcd_barrier_complete(bar, b.x, nloc, nx); b.st[0] = nloc; b.st[1] = nx; }
    const unsigned old = xb_add(&bar[XB_XSUB(b.x)], 1u);
    const unsigned gen = old / nloc;
    if (old + 1u == (gen + 1u) * nloc) {
      __builtin_amdgcn_fence(__ATOMIC_RELEASE, "agent");
      asm volatile("s_waitcnt vmcnt(0)" ::: "memory");
      const unsigned og = xb_add(&bar[XB_TOP], 1u);
      const unsigned tg = og / nx;
      if (og + 1u == (tg + 1u) * nx) xb_add(&bar[XB_TOPGEN], 1u);
      else XB_SPIN(xb_ld(&bar[XB_TOPGEN]) == tg, bar);
      __builtin_amdgcn_fence(__ATOMIC_ACQUIRE, "agent");
      xb_add(&bar[XB_XGEN(b.x)], 1u);
      asm volatile("s_waitcnt vmcnt(0)" ::: "memory");
    } else {
      XB_SPIN(xb_ld(&bar[XB_XGEN(b.x)]) == gen, bar);
      __builtin_amdgcn_fence(__ATOMIC_ACQUIRE, "agent");
      asm volatile("s_waitcnt vmcnt(0)" ::: "memory");
    }
  }
  __syncthreads();
}

__global__ void __launch_bounds__(512, 2) mega_fwd(Params P) {
  __shared__ __attribute__((aligned(16))) unsigned char smem[LDS_BYTES];
  __shared__ uint4 xb_words;
  cg::grid_group grid = cg::this_grid();
  if (P.ws == nullptr) grid.sync();
  if (threadIdx.x == 0) xb_words = make_uint4(0u, 0u, 0u, 0u);
  __syncthreads();
  XcdBarrier xbar = xcd_barrier_post((unsigned*)(P.ws + OFF_BAR), (volatile LAS unsigned*)&xb_words);
  const int G = gridDim.x, L = logical_bid();
  unsigned char* ws = P.ws;
  bf16_t* og = (bf16_t*)P.out;
  const bf16_t* xb = (const bf16_t*)(ws + OFF_XB);

  phase_prep(P, smem, L, G);
  xcd_barrier(xbar);

  phase_inproj_impl<false>(xb, 1024, 16, (const bf16_t*)(ws + OFF_WIN0T), 10, 0, P, smem, L, G);
  xcd_barrier(xbar);
  phase_attn_swa(P, P.l0_sinks, og, smem, L, G);
  xcd_barrier(xbar);
  phase_outproj<false>(P, 0, xb, og, smem, L, G);
  phase_inproj_impl<false>((const bf16_t*)(ws + OFF_PB) + (size_t)0 * MTOK * 256, 256, 4, (const bf16_t*)(ws + OFF_PPT) + (size_t)0 * 1024 * 256, 4, 5, P, smem, L, G);
  xcd_barrier(xbar);
  phase_gate<false>(P, 0, smem, L, G);
  xcd_barrier(xbar);
  phase_inproj_impl<false>(xb, 1024, 16, (const bf16_t*)(ws + OFF_WIN1T), 7, 1, P, smem, L, G);
  xcd_barrier(xbar);
  phase_mla_up(P, smem, L, G);
  xcd_barrier(xbar);
  phase_attn_mla(P, og, smem, L, G);
  xcd_barrier(xbar);
  phase_outproj<false>(P, 1, xb, og, smem, L, G);
  phase_inproj_impl<false>((const bf16_t*)(ws + OFF_PB) + (size_t)1 * MTOK * 256, 256, 4, (const bf16_t*)(ws + OFF_PPT) + (size_t)1 * 1024 * 256, 4, 5, P, smem, L, G);
  xcd_barrier(xbar);
  phase_gate<false>(P, 1, smem, L, G);
  xcd_barrier(xbar);
  phase_inproj_impl<false>(xb, 1024, 16, (const bf16_t*)(ws + OFF_WIN2T), 15, 2, P, smem, L, G);
  xcd_barrier(xbar);
  phase_cmp1(P, smem, L, G);
  xcd_barrier(xbar);
  phase_cmp2(P, smem, L, G);
  xcd_barrier(xbar);
  phase_attn_nsa(P, og, smem, L, G);
  xcd_barrier(xbar);
  phase_outproj<false>(P, 2, xb, og, smem, L, G);
  phase_inproj_impl<false>((const bf16_t*)(ws + OFF_PB) + (size_t)2 * MTOK * 256, 256, 4, (const bf16_t*)(ws + OFF_PPT) + (size_t)2 * 1024 * 256, 4, 5, P, smem, L, G);
  xcd_barrier(xbar);
  phase_gate<false>(P, 2, smem, L, G);
  xcd_barrier(xbar);
  phase_inproj_impl<false>(xb, 1024, 16, (const bf16_t*)(ws + OFF_WIN3T), 10, 0, P, smem, L, G);
  xcd_barrier(xbar);
  phase_attn_swa(P, P.l3_sinks, og, smem, L, G);
  xcd_barrier(xbar);
  phase_outproj<false>(P, 3, xb, og, smem, L, G);
  phase_inproj_impl<false>((const bf16_t*)(ws + OFF_PB) + (size_t)3 * MTOK * 256, 256, 4, (const bf16_t*)(ws + OFF_PPT) + (size_t)3 * 1024 * 256, 4, 5, P, smem, L, G);
  xcd_barrier(xbar);
  phase_gate<true>(P, 3, smem, L, G);
}

extern "C" void kernel_launch(void* const* d_in, const int* in_sizes, int n_in, void* d_out, int out_size, void* d_ws, size_t ws_size,
                              hipStream_t stream) {
  static int grid_blocks = 0;
  if (!grid_blocks) {
    int dev = 0, cus = 0, per_cu = 0;
    hipGetDevice(&dev);
    hipDeviceGetAttribute(&cus, hipDeviceAttributeMultiprocessorCount, dev);
    hipOccupancyMaxActiveBlocksPerMultiprocessor(&per_cu, mega_fwd, NTHR, 0);
    per_cu = 1;
    grid_blocks = cus * per_cu;
    if (ws_size < WS_NEED) fprintf(stderr, "kernel_launch: workspace too small: %zu < %zu\n", ws_size, (size_t)WS_NEED);
  }
  Params p{};
  p.x = (const float*)d_in[0]; p.p = (const float*)d_in[1]; p.pos = (const int*)d_in[2]; p.w_out = (const float*)d_in[3];
  p.ln_g = (const float*)d_in[4]; p.ln_b = (const float*)d_in[5]; p.pe_gate = (const float*)d_in[6]; p.pe_proj = (const float*)d_in[7];
  p.l0_w_in = (const float*)d_in[8]; p.l0_sinks = (const float*)d_in[9];
  p.l1_w_in = (const float*)d_in[10]; p.l1_q_norm = (const float*)d_in[11]; p.l1_kv_norm = (const float*)d_in[12];
  p.l1_w_uq = (const float*)d_in[13]; p.l1_w_ukv = (const float*)d_in[14];
  p.l2_w_in = (const float*)d_in[15]; p.l2_cmp_pos = (const float*)d_in[16]; p.l2_phi_k1 = (const float*)d_in[17]; p.l2_phi_k2 = (const float*)d_in[18];
  p.l2_phi_v1 = (const float*)d_in[19]; p.l2_phi_v2 = (const float*)d_in[20];
  p.l3_w_in = (const float*)d_in[21]; p.l3_sinks = (const float*)d_in[22];
  p.out = (float*)d_out; p.ws = (unsigned char*)d_ws;
  (void)hipMemsetAsync((unsigned char*)d_ws + OFF_BAR, 0, 16384, stream);
  void* args[] = {&p};
  hipError_t e = hipLaunchCooperativeKernel((void*)mega_fwd, dim3(grid_blocks), dim3(NTHR), args, 0, stream);
  if (e != hipSuccess) fprintf(stderr, "cooperative launch failed: %s (grid %d)\n", hipGetErrorString(e), grid_blocks);
}
```

```cpp
#include <hip/hip_runtime.h>
#include <hip/hip_cooperative_groups.h>
#include <stdint.h>
#include <stdio.h>
namespace cg = cooperative_groups;

typedef __attribute__((ext_vector_type(8))) short bf16x8;
typedef __attribute__((ext_vector_type(16))) float f32x16;
typedef __attribute__((ext_vector_type(2))) float f32x2_t;
typedef __attribute__((ext_vector_type(2))) __bf16 bf16x2_t;
typedef unsigned short bf16_t;

#define DI __device__ __forceinline__
#define MFMA(a, b, c) __builtin_amdgcn_mfma_f32_32x32x16_bf16((a), (b), (c), 0, 0, 0)

constexpr int SEQ = 2048;
constexpr int NB = 32;
constexpr int MTOK = NB * SEQ;
constexpr int DM = 1024;
constexpr float LOG2E = 1.4426950408889634f;
constexpr float NEGF = -1e30f;
constexpr float DN_ALPHA = 1.681792830507429f;

constexpr size_t al256(size_t x) { return (x + 255) & ~(size_t)255; }
constexpr size_t OFF_WIN0T = 0;
constexpr size_t OFF_WIN1T = OFF_WIN0T + (size_t)2560 * 1024 * 2;
constexpr size_t OFF_WIN2T = OFF_WIN1T + (size_t)1792 * 1024 * 2;
constexpr size_t OFF_WIN3T = OFF_WIN2T + (size_t)3840 * 1024 * 2;
constexpr size_t OFF_WUQT = OFF_WIN3T + (size_t)2560 * 1024 * 2;
constexpr size_t OFF_WUKVT = OFF_WUQT + (size_t)1536 * 384 * 2;
constexpr size_t OFF_PK1T = OFF_WUKVT + (size_t)2048 * 256 * 2;
constexpr size_t OFF_PV1T = OFF_PK1T + (size_t)256 * 2048 * 2;
constexpr size_t OFF_PK2T = OFF_PV1T + (size_t)256 * 2048 * 2;
constexpr size_t OFF_PV2T = OFF_PK2T + (size_t)256 * 256 * 2;
constexpr size_t OFF_WOUTT = OFF_PV2T + (size_t)256 * 256 * 2;
constexpr size_t OFF_PGT = OFF_WOUTT + (size_t)4 * 1024 * 1024 * 2;
constexpr size_t OFF_PPT = OFF_PGT + (size_t)4 * 1024 * 1024 * 2;
constexpr size_t OFF_C1 = OFF_PPT + (size_t)4 * 1024 * 256 * 2;
constexpr size_t OFF_C2 = OFF_C1 + 4 * 1024 * 4;
constexpr size_t OFF_BIAS = OFF_C2 + 4 * 1024 * 4;
constexpr size_t OFF_CS64 = OFF_BIAS + 2 * 256 * 4;
constexpr size_t OFF_CS32 = OFF_CS64 + (size_t)MTOK * 32 * 8;
constexpr size_t OFF_STATS = OFF_CS32 + (size_t)MTOK * 16 * 8;
constexpr size_t OFF_MSTAT = OFF_STATS + (size_t)MTOK * 32 * 4;
constexpr size_t OFF_XB = OFF_MSTAT + (size_t)MTOK * 16 * 4;
constexpr size_t OFF_BIG = OFF_XB + (size_t)MTOK * 1024 * 2;
constexpr size_t BIG_ELEMS = (size_t)MTOK * 5280;
constexpr size_t OFF_BAR = OFF_BIG + BIG_ELEMS * 2 + 65536;
constexpr size_t OFF_PB = OFF_BAR + 16384;
constexpr size_t WS_NEED = OFF_PB + (size_t)4 * MTOK * 256 * 2;

constexpr size_t MK = MTOK;
constexpr size_t BG_PP = MK * 1024;
constexpr size_t SW_Q = 0, SW_K = MK * 1024, SW_VT = MK * 1280, SW_Z = MK * 1536;
constexpr size_t ML_CQ = 0, ML_CKV = MK * 384, ML_Z = MK * 640, ML_KR = MK * 1664, ML_QN = MK * 1696, ML_QR = MK * 2720,
                 ML_KN = MK * 3232, ML_VT = MK * 4256;
constexpr size_t NS_Q = 0, NS_KCR = MK * 1024, NS_VCR = MK * 1280, NS_KS = MK * 1536, NS_VST = MK * 1792, NS_KW = MK * 2048,
                 NS_VWT = MK * 2304, NS_Z = MK * 2560, NS_GL = MK * 3584, NS_HK = MK * 3648, NS_HV = MK * 3712,
                 NS_KC2 = MK * 3776, NS_VCT = MK * 3792;

constexpr int NTHR = 512;
constexpr int LDS_TILE = 256 * 72;
constexpr int LDS_GEMM_BYTES = 4 * LDS_TILE * 2;
constexpr int LDS_ROW_OFF = LDS_GEMM_BYTES;
constexpr int LDS_VEC_OFF = LDS_GEMM_BYTES + 2048;
constexpr int LDS_BYTES = LDS_GEMM_BYTES + 2048 + 4096;
constexpr int ATT_LDS = 73728;

struct Params {
  const float* x; const float* p; const int* pos; const float* w_out; const float* ln_g; const float* ln_b;
  const float* pe_gate; const float* pe_proj;
  const float* l0_w_in; const float* l0_sinks;
  const float* l1_w_in; const float* l1_q_norm; const float* l1_kv_norm; const float* l1_w_uq; const float* l1_w_ukv;
  const float* l2_w_in; const float* l2_cmp_pos; const float* l2_phi_k1; const float* l2_phi_k2; const float* l2_phi_v1; const float* l2_phi_v2;
  const float* l3_w_in; const float* l3_sinks;
  float* out; unsigned char* ws;
};

DI unsigned pack2(float a, float b) { f32x2_t v = {a, b}; bf16x2_t r = __builtin_convertvector(v, bf16x2_t); return __builtin_bit_cast(unsigned, r); }
DI bf16_t f2bf(float a) { return (bf16_t)(pack2(a, 0.f) & 0xffffu); }
DI float bf2f(bf16_t b) { return __uint_as_float(((unsigned)b) << 16); }
DI float bflo(unsigned u) { return __uint_as_float(u << 16); }
DI float bfhi(unsigned u) { return __uint_as_float(u & 0xffff0000u); }
DI float fexp2(float x) { return __builtin_amdgcn_exp2f(x); }
DI float sigmoidf_(float x) { return __builtin_amdgcn_rcpf(1.f + __expf(-x)); }
DI float siluf_(float x) { return x * __builtin_amdgcn_rcpf(1.f + __expf(-x)); }
DI int crow(int reg, int h) { return (reg & 3) + 8 * (reg >> 2) + 4 * h; }
DI float shx(float v, int m) { return __shfl_xor(v, m, 64); }
DI int otid() { int t = threadIdx.x; asm volatile("" : "+v"(t)); return t; }

DI float rowsum16(const float (&v)[16], int c) {
  float w8[8], w4[4], w2[2];
  const bool b4 = c & 16, b3 = c & 8, b2 = c & 4, b1 = c & 2;
#pragma unroll
  for (int k = 0; k < 8; ++k) { float send = b4 ? v[k] : v[k + 8]; float keep = b4 ? v[k + 8] : v[k]; w8[k] = keep + shx(send, 16); }
#pragma unroll
  for (int k = 0; k < 4; ++k) { float send = b3 ? w8[k] : w8[k + 4]; float keep = b3 ? w8[k + 4] : w8[k]; w4[k] = keep + shx(send, 8); }
#pragma unroll
  for (int k = 0; k < 2; ++k) { float send = b2 ? w4[k] : w4[k + 2]; float keep = b2 ? w4[k + 2] : w4[k]; w2[k] = keep + shx(send, 4); }
  float send = b1 ? w2[0] : w2[1]; float keep = b1 ? w2[1] : w2[0];
  float w1 = keep + shx(send, 2);
  return w1 + shx(w1, 1);
}
DI int rowsum_idx(int c) { return ((c >> 4) & 1) * 8 + ((c >> 3) & 1) * 4 + ((c >> 2) & 1) * 2 + ((c >> 1) & 1); }

struct ARowPlain { const bf16_t* A; int lda; DI const bf16_t* operator()(int row, int kt) const { return A + (size_t)row * lda + kt * 64; } };
struct ARowF32 { const float* A; int lda; DI const float* operator()(int row, int kt) const { return A + (size_t)row * lda + kt * 64; } };
struct ARowCmp { const bf16_t* base; DI const bf16_t* operator()(int row, int kt) const {
  int b = row >> 9, n = (row >> 2) & 127, g = row & 3; return base + ((size_t)(b * SEQ + n * 16 + kt)) * 256 + g * 64; } };

typedef unsigned u32x4 __attribute__((ext_vector_type(4)));
typedef float f32x4 __attribute__((ext_vector_type(4)));
DI u32x4 ldg16(const void* p) { return *(const u32x4*)p; }
DI void stg16_nt(void* p, u32x4 v) { __builtin_nontemporal_store(v, (u32x4*)p); }
DI f32x4 ldgf4(const float* p) { return *(const f32x4*)p; }
DI u32x4 cvt8(f32x4 a, f32x4 b) { u32x4 r; r.x = pack2(a.x, a.y); r.y = pack2(a.z, a.w); r.z = pack2(b.x, b.y); r.w = pack2(b.z, b.w); return r; }

struct GR { u32x4 a0, a1, a2, a3, b0, b1, b2, b3; };
#define GL_LOADA(i, kt) { R.a##i = ldg16((const bf16_t*)ar(m0 + lrow + 64 * i, kt) + lkc * 8); \
                          R.b##i = ldg16(Bt + (size_t)(n0 + lrow + 64 * i) * ldb + (kt) * 64 + lkc * 8); }
#define GL_STORE(i) { *(u32x4*)(sA + (lrow + 64 * i) * 72 + lkc * 8) = R.a##i; *(u32x4*)(sB + (lrow + 64 * i) * 72 + lkc * 8) = R.b##i; }

template <bool AF32, class AR>
DI void gemm_first(GR& R, const AR& ar, const bf16_t* __restrict__ Bt, int ldb, int m0, int n0) {
  const int tid = otid();
  const int lrow = tid >> 3, lkc = tid & 7;
  GL_LOADA(0, 0) GL_LOADA(1, 0) GL_LOADA(2, 0) GL_LOADA(3, 0)
}

template <bool AF32, class AR>
DI void gemm_loop(f32x16 (&acc)[4][2], GR& R, const AR& ar, const bf16_t* __restrict__ Bt, int ldb, int m0, int n0, int nk, bf16_t* lds, bool swp) {
  const int tid = otid();
  const int lane = tid & 63, w = tid >> 6, r = lane & 31, h = lane >> 5;
  const int wm = w >> 2, wn = w & 3;
  const int lrow = tid >> 3, lkc = tid & 7;
  {
    bf16_t* sA = lds; bf16_t* sB = lds + 2 * LDS_TILE;
    GL_STORE(0) GL_STORE(1) GL_STORE(2) GL_STORE(3)
  }
  if (1 < nk) { GL_LOADA(0, 1) GL_LOADA(1, 1) GL_LOADA(2, 1) GL_LOADA(3, 1) }
  __syncthreads();
  for (int kt = 0; kt < nk; ++kt) {
    const bool wr = kt + 1 < nk, ld = kt + 2 < nk;
    bf16_t* sA = lds + ((kt + 1) & 1) * LDS_TILE;
    bf16_t* sB = lds + 2 * LDS_TILE + ((kt + 1) & 1) * LDS_TILE;
    const bf16_t* cA = lds + (kt & 1) * LDS_TILE;
    const bf16_t* cB = lds + 2 * LDS_TILE + (kt & 1) * LDS_TILE;
    const bf16_t* pa = (swp ? cB : cA) + (wm * 128 + r) * 72 + 8 * h;
    const bf16_t* pb = (swp ? cA : cB) + (wn * 64 + r) * 72 + 8 * h;
#define FR_LOAD(ks, P) { P##a0 = *(const bf16x8*)(pa + (ks) * 16); P##a1 = *(const bf16x8*)(pa + 32 * 72 + (ks) * 16); \
                         P##a2 = *(const bf16x8*)(pa + 64 * 72 + (ks) * 16); P##a3 = *(const bf16x8*)(pa + 96 * 72 + (ks) * 16); \
                         P##b0 = *(const bf16x8*)(pb + (ks) * 16); P##b1 = *(const bf16x8*)(pb + 32 * 72 + (ks) * 16); }
#define FR_MMA(P) { acc[0][0] = MFMA(P##a0, P##b0, acc[0][0]); acc[0][1] = MFMA(P##a0, P##b1, acc[0][1]); \
                    acc[1][0] = MFMA(P##a1, P##b0, acc[1][0]); acc[1][1] = MFMA(P##a1, P##b1, acc[1][1]); \
                    acc[2][0] = MFMA(P##a2, P##b0, acc[2][0]); acc[2][1] = MFMA(P##a2, P##b1, acc[2][1]); \
                    acc[3][0] = MFMA(P##a3, P##b0, acc[3][0]); acc[3][1] = MFMA(P##a3, P##b1, acc[3][1]); }
#define K_STEP(ks) { bf16x8 xa0, xa1, xa2, xa3, xb0, xb1; FR_LOAD(ks, x) FR_MMA(x) \
                     if (wr) GL_STORE(ks) if (ld) GL_LOADA(ks, kt + 2) __builtin_amdgcn_sched_barrier(0); }
    K_STEP(0) K_STEP(1) K_STEP(2) K_STEP(3)
#undef K_STEP
    __syncthreads();
  }
}

DI void acc_zero(f32x16 (&acc)[4][2]) {
#pragma unroll
  for (int i = 0; i < 4; ++i)
#pragma unroll
    for (int j = 0; j < 2; ++j)
#pragma unroll
      for (int q = 0; q < 16; ++q) acc[i][j][q] = 0.f;
}

enum { K_PLAIN = 0, K_ROPE64 = 1, K_ROPE32 = 2, K_VT = 3, K_SILU = 4, K_KC2 = 5, K_VCT = 6, K_NONE = 7 };
struct Seg {
  int kind; bf16_t* dst; int ld; int cbase; int G; int nvalid;
  float* stat; int statbase;
  const float* bias;
};
DI bool seg_swapped(int kind) { return kind != K_VT && kind != K_VCT; }

constexpr int STG = 260;
DI void stage_acc(bf16_t* stg, const f32x16 (&acc)[4][2], int wm, int wn, int r, int h) {
#pragma unroll
  for (int i = 0; i < 4; ++i)
#pragma unroll
    for (int j = 0; j < 2; ++j)
#pragma unroll
      for (int q4 = 0; q4 < 4; ++q4) {
        uint2 pk;
        pk.x = pack2(acc[i][j][4 * q4], acc[i][j][4 * q4 + 1]);
        pk.y = pack2(acc[i][j][4 * q4 + 2], acc[i][j][4 * q4 + 3]);
        *(uint2*)(stg + (wn * 64 + j * 32 + r) * STG + wm * 128 + i * 32 + 8 * q4 + 4 * h) = pk;
      }
}
DI u32x4 stage_read16(const bf16_t* stg, int rr, int c) {
  const uint2 lo = *(const uint2*)(stg + rr * STG + c * 8);
  const uint2 hi = *(const uint2*)(stg + rr * STG + c * 8 + 4);
  u32x4 v; v.x = lo.x; v.y = lo.y; v.z = hi.x; v.w = hi.y; return v;
}
DI void stage_write16(bf16_t* stg, int rr, int c, u32x4 v) {
  *(uint2*)(stg + rr * STG + c * 8) = make_uint2(v.x, v.y);
  *(uint2*)(stg + rr * STG + c * 8 + 4) = make_uint2(v.z, v.w);
}
template <bool NT>
DI void stage_load_tile(bf16_t* stg, const bf16_t* tilebase) {
  const int tid = otid();
  const int r0 = tid >> 5, c = tid & 31;
  const unsigned o0 = (unsigned)(r0 * 1024 + c * 8);
  __builtin_amdgcn_sched_barrier(0);
#pragma unroll
  for (int hf = 0; hf < 2; ++hf) {
#pragma unroll
    for (int it = 8 * hf; it < 8 * hf + 8; ++it) {
      const u32x4* gp = (const u32x4*)(tilebase + (o0 + (unsigned)(it * 16 * 1024)));
      stage_write16(stg, r0 + 16 * it, c, NT ? __builtin_nontemporal_load(gp) : *gp);
    }
    __builtin_amdgcn_sched_barrier(0);
  }
}
DI void stage_store_tile(const bf16_t* stg, bf16_t* tilebase) {
  const int tid = otid();
  const int r0 = tid >> 5, c = tid & 31;
  const unsigned o0 = (unsigned)(r0 * 1024 + c * 8);
#pragma unroll
  for (int it = 0; it < 16; ++it) stg16_nt(tilebase + (o0 + (unsigned)(it * 16 * 1024)), stage_read16(stg, r0 + 16 * it, c));
}

DI void epi_seg(const f32x16 (&acc)[4][2], const Seg& sg0, const Seg& sg1, int m0, int n0, const float* rs, const float2* cs64, const float2* cs32, bf16_t* stg) {
  const int tid = otid();
  const int lane = tid & 63, w = tid >> 6, r = lane & 31, h = lane >> 5;
  const int wm = w >> 2, wn = w & 3;
  const int kind0 = sg0.kind;
  if (kind0 == K_VCT) {
    if (wn == 0) {
#pragma unroll
      for (int i = 0; i < 4; ++i)
#pragma unroll
        for (int q = 0; q < 16; ++q) {
          const int row = m0 + wm * 128 + i * 32 + crow(q, h);
          const int b = row >> 9, n = (row >> 2) & 127, g = row & 3;
#pragma unroll
          for (int j = 0; j < 2; ++j) sg0.dst[((size_t)((b * 4 + g) * 64 + j * 32 + r)) * 128 + n] = f2bf(acc[i][j][q]);
        }
    }
    __syncthreads();
    return;
  }
  if (kind0 == K_VT) {
#pragma unroll
    for (int i = 0; i < 4; ++i)
#pragma unroll
      for (int q4 = 0; q4 < 4; ++q4) {
        const int t0l = wm * 128 + i * 32 + 8 * q4 + 4 * h;
        float s0 = 1.f, s1 = 1.f, s2 = 1.f, s3 = 1.f;
        if (rs) { s0 = rs[t0l]; s1 = rs[t0l + 1]; s2 = rs[t0l + 2]; s3 = rs[t0l + 3]; }
#pragma unroll
        for (int j = 0; j < 2; ++j)
          *(uint2*)(stg + (wn * 64 + j * 32 + r) * STG + t0l) =
              make_uint2(pack2(acc[i][j][4 * q4] * s0, acc[i][j][4 * q4 + 1] * s1), pack2(acc[i][j][4 * q4 + 2] * s2, acc[i][j][4 * q4 + 3] * s3));
      }
    __syncthreads();
    const int b = m0 >> 11, s0 = m0 & (SEQ - 1);
#pragma unroll
    for (int it = 0; it < 16; ++it) {
      const int idx = tid + NTHR * it, rr = idx >> 5, c = idx & 31;
      const int lc = n0 + rr - sg0.cbase, g = lc >> 6, d = lc & 63;
      stg16_nt(sg0.dst + ((size_t)((b * sg0.G + g) * 64 + d)) * SEQ + s0 + c * 8, stage_read16(stg, rr, c));
    }
    __syncthreads();
    return;
  }
  const Seg& sg = wm ? sg1 : sg0;
  const int kind = sg.kind;
  const int lcw = n0 + wm * 128 - sg.cbase;
  const bool wvalid = (kind != K_NONE) && (lcw < sg.nvalid);
  if (wvalid) {
#pragma unroll
    for (int j = 0; j < 2; ++j) {
      const int lrow = wn * 64 + j * 32 + r;
      const float sc = rs ? rs[lrow] : 1.f;
      bf16_t* srow = stg + lrow * STG + wm * 128 + 4 * h;
      if (kind == K_ROPE64 || kind == K_KC2) {
        const int row = m0 + lrow;
        size_t tok = row;
        if (kind == K_KC2) { const int b = row >> 9, n = (row >> 2) & 127; int t = n * 16 + 31; if (t > SEQ - 1) t = SEQ - 1; tok = (size_t)b * SEQ + t; }
        const f32x4* cp = (const f32x4*)(cs64 + tok * 32);
#pragma unroll
        for (int q4 = 0; q4 < 4; ++q4) {
          const f32x4 c01 = cp[(8 * q4 + 4 * h) / 2], c23 = cp[(8 * q4 + 4 * h) / 2 + 1];
          const float cc[4] = {c01.x, c01.z, c23.x, c23.z}, sn[4] = {c01.y, c01.w, c23.y, c23.w};
#pragma unroll
          for (int hd = 0; hd < 2; ++hd) {
            float o1[4], o2[4];
#pragma unroll
            for (int e = 0; e < 4; ++e) {
              const float x1 = acc[2 * hd][j][4 * q4 + e], x2 = acc[2 * hd + 1][j][4 * q4 + e];
              o1[e] = x1 * cc[e] - x2 * sn[e]; o2[e] = x2 * cc[e] + x1 * sn[e];
            }
            *(uint2*)(srow + (2 * hd) * 32 + 8 * q4) = make_uint2(pack2(o1[0], o1[1]), pack2(o1[2], o1[3]));
            *(uint2*)(srow + (2 * hd + 1) * 32 + 8 * q4) = make_uint2(pack2(o2[0], o2[1]), pack2(o2[2], o2[3]));
          }
        }
      } else if (kind == K_ROPE32) {
        const size_t tok = (size_t)(m0 + lrow);
        const f32x4* cp = (const f32x4*)(cs32 + tok * 16);
#pragma unroll
        for (int q4 = 0; q4 < 2; ++q4) {
          const f32x4 c01 = cp[(8 * q4 + 4 * h) / 2], c23 = cp[(8 * q4 + 4 * h) / 2 + 1];
          const float cc[4] = {c01.x, c01.z, c23.x, c23.z}, sn[4] = {c01.y, c01.w, c23.y, c23.w};
#pragma unroll
          for (int i = 0; i < 4; ++i) {
            float o1[4], o2[4];
#pragma unroll
            for (int e = 0; e < 4; ++e) {
              const float x1 = acc[i][j][4 * q4 + e] * sc, x2 = acc[i][j][4 * q4 + e + 8] * sc;
              o1[e] = x1 * cc[e] - x2 * sn[e]; o2[e] = x2 * cc[e] + x1 * sn[e];
            }
            *(uint2*)(srow + i * 32 + 8 * q4) = make_uint2(pack2(o1[0], o1[1]), pack2(o1[2], o1[3]));
            *(uint2*)(srow + i * 32 + 8 * (q4 + 2)) = make_uint2(pack2(o2[0], o2[1]), pack2(o2[2], o2[3]));
          }
        }
      } else {
#pragma unroll
        for (int ch = 0; ch < 2; ++ch) {
          float ss = 0.f;
#pragma unroll
          for (int i = 2 * ch; i < 2 * ch + 2; ++i)
#pragma unroll
            for (int q4 = 0; q4 < 4; ++q4) {
              float v[4] = {acc[i][j][4 * q4] * sc, acc[i][j][4 * q4 + 1] * sc, acc[i][j][4 * q4 + 2] * sc, acc[i][j][4 * q4 + 3] * sc};
              if (kind == K_SILU) {
                const f32x4 bv = *(const f32x4*)(sg.bias + lcw + i * 32 + 8 * q4 + 4 * h);
                v[0] = siluf_(v[0] + bv.x); v[1] = siluf_(v[1] + bv.y); v[2] = siluf_(v[2] + bv.z); v[3] = siluf_(v[3] + bv.w);
              }
              const uint2 pk = make_uint2(pack2(v[0], v[1]), pack2(v[2], v[3]));
              *(uint2*)(srow + i * 32 + 8 * q4) = pk;
              const float f0 = bflo(pk.x), f1 = bfhi(pk.x), f2 = bflo(pk.y), f3 = bfhi(pk.y);
              ss += (f0 * f0 + f1 * f1) + (f2 * f2 + f3 * f3);
            }
          if (sg.stat) {
            ss += shx(ss, 32);
            if (h == 0 && lcw + ch * 64 < sg.nvalid) sg.stat[(size_t)(m0 + lrow) * 16 + sg.statbase + (lcw >> 6) + ch] = ss;
          }
        }
      }
    }
  }
  __syncthreads();
#pragma unroll
  for (int it = 0; it < 16; ++it) {
    const int idx = tid + NTHR * it, rr = idx >> 5, c = idx & 31;
    const Seg& fs = (c >> 4) ? sg1 : sg0;
    const int lcc = n0 + c * 8 - fs.cbase;
    if (fs.kind != K_NONE && lcc < fs.nvalid) {
      const int row = m0 + rr;
      size_t off;
      if (fs.kind == K_KC2) { const int b = row >> 9, n = (row >> 2) & 127, g = row & 3; off = ((size_t)((b * 4 + g) * 128 + n)) * 64 + lcc; }
      else off = (size_t)row * fs.ld + lcc;
      stg16_nt(fs.dst + off, stage_read16(stg, rr, c));
    }
  }
  __syncthreads();
}

DI int kperm(int r) { return (r & 0x13) | ((r & 8) >> 1) | ((r & 4) << 1); }

template <int DQK, bool MASKED, int MODE, class MF>
DI void attn_step(const bf16_t* sK, const bf16_t* sVt, const bf16x8 (&qf)[DQK / 16], f32x16& o0, f32x16& o1, float& m, float& l,
                  float sc, const MF& mf, int lane, f32x16 (&s)[2], float invl, bool lanevalid = true) {
  const int r = lane & 31, h = lane >> 5;
  const int pr = kperm(r);
  constexpr int KST = DQK + 8;
  bf16x8 kf[2][DQK / 16];
#pragma unroll
  for (int sub = 0; sub < 2; ++sub)
#pragma unroll
    for (int ks = 0; ks < DQK / 16; ++ks) kf[sub][ks] = *(const bf16x8*)(sK + (sub * 32 + pr) * KST + ks * 16 + 8 * h);
  __builtin_amdgcn_sched_barrier(0);
#pragma unroll
  for (int q = 0; q < 16; ++q) { s[0][q] = 0.f; s[1][q] = 0.f; }
#pragma unroll
  for (int ks = 0; ks < DQK / 16; ++ks) {
    s[0] = MFMA(kf[0][ks], qf[ks], s[0]);
    s[1] = MFMA(kf[1][ks], qf[ks], s[1]);
  }
  bf16x8 vf[2][2][2];
  if (MODE != 1) {
#pragma unroll
    for (int sub = 0; sub < 2; ++sub)
#pragma unroll
      for (int s2 = 0; s2 < 2; ++s2) {
        vf[sub][s2][0] = *(const bf16x8*)(sVt + r * 72 + sub * 32 + s2 * 16 + 8 * h);
        vf[sub][s2][1] = *(const bf16x8*)(sVt + (32 + r) * 72 + sub * 32 + s2 * 16 + 8 * h);
      }
    __builtin_amdgcn_sched_barrier(0);
  }
  float mxr = -3.0e38f;
#pragma unroll
  for (int sub = 0; sub < 2; ++sub)
#pragma unroll
    for (int q = 0; q < 16; ++q) {
      if (MASKED) { const int kk = sub * 32 + 16 * (q >> 3) + 8 * h + (q & 7); s[sub][q] = mf(kk) ? s[sub][q] : -3.0e38f; }
      if (MODE != 2) mxr = fmaxf(mxr, s[sub][q]);
    }
  float alpha = 1.f;
  if (MODE != 2) {
    float mx = fmaxf(m, mxr * sc);
    mx = fmaxf(mx, shx(mx, 32));
    if (!MASKED) mx = lanevalid ? mx : m;
    alpha = fexp2(m - mx);
    m = mx;
  }
  const float moff = (!MASKED && !lanevalid) ? 1.0e30f : m;
  float ps = 0.f;
#pragma unroll
  for (int sub = 0; sub < 2; ++sub)
#pragma unroll
    for (int q = 0; q < 16; ++q) {
      float pv = fexp2(__builtin_fmaf(s[sub][q], sc, -moff));
      if (MASKED && MODE != 0) pv = (s[sub][q] > -1.0e38f) ? pv : 0.f;
      if (MODE == 2) pv *= invl;
      s[sub][q] = pv;
      ps += pv;
    }
  if (MODE != 2) {
    ps += shx(ps, 32);
    l = l * alpha + ps;
  }
  if (MODE == 1) return;
  if (MODE == 0) {
#pragma unroll
    for (int q = 0; q < 16; ++q) { o0[q] *= alpha; o1[q] *= alpha; }
  }
#pragma unroll
  for (int sub = 0; sub < 2; ++sub)
#pragma unroll
    for (int s2 = 0; s2 < 2; ++s2) {
      union { bf16x8 v; unsigned u[4]; } pb;
#pragma unroll
      for (int e = 0; e < 4; ++e) pb.u[e] = pack2(s[sub][8 * s2 + 2 * e], s[sub][8 * s2 + 2 * e + 1]);
      o0 = MFMA(vf[sub][s2][0], pb.v, o0);
      o1 = MFMA(vf[sub][s2][1], pb.v, o1);
    }
}

constexpr int KVB64 = 2 * 64 * 72;
constexpr int KVB96 = 64 * 104 + 64 * 72;
struct KVR { u32x4 k0, k1, k2, v0, v1; };
DI void kv64_fetch(KVR& R, const bf16_t* kbase, int kstride, const bf16_t* vtbase, int vtstride, int key0, bool withV, int tid) {
  const int row0 = tid >> 3, kc = tid & 7, row1 = row0 + 32;
  R.k0 = ldg16(kbase + (size_t)(key0 + row0) * kstride + kc * 8);
  R.k1 = ldg16(kbase + (size_t)(key0 + row1) * kstride + kc * 8);
  if (withV) { R.v0 = ldg16(vtbase + (size_t)row0 * vtstride + key0 + kc * 8); R.v1 = ldg16(vtbase + (size_t)row1 * vtstride + key0 + kc * 8); }
}
DI void kv64_commit(const KVR& R, bf16_t* sK, bf16_t* sVt, bool withV, int tid) {
  const int row0 = tid >> 3, kc = tid & 7, row1 = row0 + 32;
  __syncthreads();
  *(u32x4*)(sK + row0 * 72 + kc * 8) = R.k0;
  *(u32x4*)(sK + row1 * 72 + kc * 8) = R.k1;
  if (withV) { *(u32x4*)(sVt + row0 * 72 + kc * 8) = R.v0; *(u32x4*)(sVt + row1 * 72 + kc * 8) = R.v1; }
  __syncthreads();
}
DI void kv64_store(const KVR& R, bf16_t* sK, bf16_t* sVt, int tid) {
  const int row0 = tid >> 3, kc = tid & 7, row1 = row0 + 32;
  *(u32x4*)(sK + row0 * 72 + kc * 8) = R.k0;
  *(u32x4*)(sK + row1 * 72 + kc * 8) = R.k1;
  *(u32x4*)(sVt + row0 * 72 + kc * 8) = R.v0;
  *(u32x4*)(sVt + row1 * 72 + kc * 8) = R.v1;
}
DI void kv96_store(const KVR& R, bf16_t* sK, bf16_t* sVt, int tid) {
  const int row0 = tid >> 3, kc = tid & 7, row1 = row0 + 32;
  const int rr = tid >> 2, rc = tid & 3;
  *(u32x4*)(sK + row0 * 104 + kc * 8) = R.k0;
  *(u32x4*)(sK + row1 * 104 + kc * 8) = R.k1;
  *(u32x4*)(sK + rr * 104 + 64 + rc * 8) = R.k2;
  *(u32x4*)(sVt + row0 * 72 + kc * 8) = R.v0;
  *(u32x4*)(sVt + row1 * 72 + kc * 8) = R.v1;
}
DI void kv96_fetch(KVR& R, const bf16_t* knbase  , const bf16_t* krbase, const bf16_t* vtbase, int key0, int tid) {
  const int row0 = tid >> 3, kc = tid & 7, row1 = row0 + 32;
  const int rr = tid >> 2, rc = tid & 3;
  R.k0 = ldg16(knbase + (size_t)(key0 + row0) * 1024 + kc * 8);
  R.k1 = ldg16(knbase + (size_t)(key0 + row1) * 1024 + kc * 8);
  R.k2 = ldg16(krbase + (size_t)(key0 + rr) * 32 + rc * 8);
  R.v0 = ldg16(vtbase + (size_t)row0 * SEQ + key0 + kc * 8);
  R.v1 = ldg16(vtbase + (size_t)row1 * SEQ + key0 + kc * 8);
}
DI void kv96_commit(const KVR& R, bf16_t* sK, bf16_t* sVt, int tid) {
  const int row0 = tid >> 3, kc = tid & 7, row1 = row0 + 32;
  const int rr = tid >> 2, rc = tid & 3;
  __syncthreads();
  *(u32x4*)(sK + row0 * 104 + kc * 8) = R.k0;
  *(u32x4*)(sK + row1 * 104 + kc * 8) = R.k1;
  *(u32x4*)(sK + rr * 104 + 64 + rc * 8) = R.k2;
  *(u32x4*)(sVt + row0 * 72 + kc * 8) = R.v0;
  *(u32x4*)(sVt + row1 * 72 + kc * 8) = R.v1;
  __syncthreads();
}

DI void o_zero(f32x16& a, f32x16& b) {
#pragma unroll
  for (int q = 0; q < 16; ++q) { a[q] = 0.f; b[q] = 0.f; }
}

DI int logical_bid() {
  const int G = gridDim.x, bx = blockIdx.x;
  return (G % 8 == 0) ? (bx % 8) * (G / 8) + bx / 8 : bx;
}

DI int colmap(int kind, int n) {
  switch (kind) {
    case 0: return n;
    case 1: return n < 640 ? n : (n < 1664 ? n + 32 : (n < 1696 ? n - 1024 : -1));
    case 2: if (n < 1024) return (n >> 6) * 96 + (n & 63); else { int m = n - 1024; return (m >> 5) * 96 + 64 + (m & 31); }
    case 3: if (n < 1024) return (n >> 6) * 128 + (n & 63); else { int m = n - 1024; return (m >> 6) * 128 + 64 + (m & 63); }
    case 4: return n < 2560 ? n : (n < 3584 ? n + 48 : (n < 3632 ? n - 1024 : -1));
    default: return n < 64 ? n : -1;
  }
}

DI void prep_transpose(const float* W, int K, int Nsrc, int Nd, int kind, const float* kscale, bf16_t* dst, float* tileL, int L, int G) {
  const int tid = otid();
  const int ktiles = K / 64, ntiles = Nd / 64;
  for (int t = L; t < ktiles * ntiles; t += G) {
    const int nt = t / ktiles, kt = t - nt * ktiles;
    const int k0 = kt * 64, n0 = nt * 64;
    const int tx = tid & 63, ty = tid >> 6;
    const int src = colmap(kind, n0 + tx);
    __syncthreads();
    for (int kk = ty; kk < 64; kk += 8) {
      float v = 0.f;
      if (src >= 0) { v = W[(size_t)(k0 + kk) * Nsrc + src]; if (kscale) v *= kscale[k0 + kk]; }
      tileL[kk * 65 + tx] = v;
    }
    __syncthreads();
    const int nl = tid >> 3, kq = tid & 7;
    unsigned pk[4];
#pragma unroll
    for (int e = 0; e < 4; ++e) pk[e] = pack2(tileL[(kq * 8 + 2 * e) * 65 + nl], tileL[(kq * 8 + 2 * e + 1) * 65 + nl]);
    *(uint4*)(dst + (size_t)(n0 + nl) * K + k0 + kq * 8) = make_uint4(pk[0], pk[1], pk[2], pk[3]);
  }
}

DI void phase_prep(const Params& P, unsigned char* smem, int L, int G) {
  unsigned char* ws = P.ws;
  float* tileL = (float*)smem;
  const int tid = otid();
  prep_transpose(P.l0_w_in, 1024, 2560, 2560, 0, nullptr, (bf16_t*)(ws + OFF_WIN0T), tileL, L, G);
  prep_transpose(P.l1_w_in, 1024, 1696, 1792, 1, nullptr, (bf16_t*)(ws + OFF_WIN1T), tileL, L, G);
  prep_transpose(P.l2_w_in, 1024, 3632, 3840, 4, nullptr, (bf16_t*)(ws + OFF_WIN2T), tileL, L, G);
  prep_transpose(P.l3_w_in, 1024, 2560, 2560, 0, nullptr, (bf16_t*)(ws + OFF_WIN3T), tileL, L, G);
  prep_transpose(P.l1_w_uq, 384, 1536, 1536, 2, P.l1_q_norm, (bf16_t*)(ws + OFF_WUQT), tileL, L, G);
  prep_transpose(P.l1_w_ukv, 256, 2048, 2048, 3, P.l1_kv_norm, (bf16_t*)(ws + OFF_WUKVT), tileL, L, G);
  prep_transpose(P.l2_phi_k1, 2048, 256, 256, 0, nullptr, (bf16_t*)(ws + OFF_PK1T), tileL, L, G);
  prep_transpose(P.l2_phi_v1, 2048, 256, 256, 0, nullptr, (bf16_t*)(ws + OFF_PV1T), tileL, L, G);
  prep_transpose(P.l2_phi_k2, 256, 64, 256, 5, nullptr, (bf16_t*)(ws + OFF_PK2T), tileL, L, G);
  prep_transpose(P.l2_phi_v2, 256, 64, 256, 5, nullptr, (bf16_t*)(ws + OFF_PV2T), tileL, L, G);
  for (int i = 0; i < 4; ++i) {
    prep_transpose(P.w_out + (size_t)i * 1024 * 1024, 1024, 1024, 1024, 0, nullptr, (bf16_t*)(ws + OFF_WOUTT) + (size_t)i * 1024 * 1024, tileL, L, G);
    prep_transpose(P.pe_gate + (size_t)i * 1024 * 1024, 1024, 1024, 1024, 0, P.ln_g + i * 1024, (bf16_t*)(ws + OFF_PGT) + (size_t)i * 1024 * 1024, tileL, L, G);
    prep_transpose(P.pe_proj + (size_t)i * 256 * 1024, 256, 1024, 1024, 0, nullptr, (bf16_t*)(ws + OFF_PPT) + (size_t)i * 1024 * 256, tileL, L, G);
  }
  __syncthreads();
  {
    float* red = (float*)smem;
    float* c1 = (float*)(ws + OFF_C1); float* c2 = (float*)(ws + OFF_C2);
    for (int t = L; t < 128; t += G) {
      const int i = t >> 5, n0 = (t & 31) * 32;
      const int kp = tid >> 5, nn = tid & 31;
      const float* W = P.pe_gate + (size_t)i * 1024 * 1024;
      const float* g = P.ln_g + i * 1024; const float* bb = P.ln_b + i * 1024;
      float s1 = 0.f, s2 = 0.f;
      for (int k = kp * 64; k < kp * 64 + 64; ++k) {
        const float wv = W[(size_t)k * 1024 + n0 + nn];
        s1 += bf2f(f2bf(g[k] * wv)); s2 += bb[k] * wv;
      }
      __syncthreads();
      red[kp * 32 + nn] = s1; red[512 + kp * 32 + nn] = s2;
      __syncthreads();
      if (tid < 32) {
        float a = 0.f, b2 = 0.f;
        for (int q = 0; q < 16; ++q) { a += red[q * 32 + tid]; b2 += red[512 + q * 32 + tid]; }
        c1[i * 1024 + n0 + tid] = a; c2[i * 1024 + n0 + tid] = b2;
      }
    }
    __syncthreads();
    float* bias = (float*)(ws + OFF_BIAS);
    for (int t = L; t < 16; t += G) {
      const int which = t >> 3, n0 = (t & 7) * 32;
      const int kp = tid >> 5, nn = tid & 31;
      const float* W = which ? P.l2_phi_v1 : P.l2_phi_k1;
      float s1 = 0.f;
      for (int k = kp * 128; k < kp * 128 + 128; ++k) s1 += P.l2_cmp_pos[k] * W[(size_t)k * 256 + n0 + nn];
      __syncthreads();
      red[kp * 32 + nn] = s1;
      __syncthreads();
      if (tid < 32) { float a = 0.f; for (int q = 0; q < 16; ++q) a += red[q * 32 + tid]; bias[which * 256 + n0 + tid] = a; }
    }
  }
  {
    bf16_t* xbw = (bf16_t*)(ws + OFF_XB); bf16_t* pbw = (bf16_t*)(ws + OFF_PB);
    const size_t nx8 = (size_t)MTOK * 1024 / 8, np8 = (size_t)4 * MTOK * 256 / 8;
    for (size_t idx = (size_t)L * NTHR + tid; idx < nx8 + np8; idx += (size_t)G * NTHR) {
      const bool isx = idx < nx8;
      const size_t e = (isx ? idx : idx - nx8) * 8;
      const float* src = (isx ? P.x : P.p) + e;
      const f32x4 f0 = ldgf4(src), f1 = ldgf4(src + 4);
      *(u32x4*)((isx ? xbw : pbw) + e) = cvt8(f0, f1);
    }
  }
  {
    float2* cs64 = (float2*)(ws + OFF_CS64); float2* cs32 = (float2*)(ws + OFF_CS32);
    const size_t total = (size_t)MTOK * 48;
    for (size_t idx = (size_t)L * NTHR + tid; idx < total; idx += (size_t)G * NTHR) {
      const int tok = (int)(idx / 48), e = (int)(idx - (size_t)tok * 48);
      const float posf = (float)P.pos[tok];
      float sn, cn;
      if (e < 32) { const float inv = powf(10000.f, -(float)e / 32.f); sincosf(posf * inv, &sn, &cn); cs64[(size_t)tok * 32 + e] = make_float2(cn, sn); }
      else { const int e2 = e - 32; const float inv = powf(10000.f, -(float)e2 / 16.f); sincosf(posf * inv, &sn, &cn); cs32[(size_t)tok * 16 + e2] = make_float2(cn, sn); }
    }
  }
}

DI Seg seg_for(int mixer, int nt, bf16_t* big, float* mstat) {
  Seg s; s.kind = K_PLAIN; s.dst = big; s.ld = 1024; s.cbase = 0; s.G = 4; s.nvalid = 1 << 30; s.stat = nullptr; s.statbase = 0; s.bias = nullptr;
  if (mixer == 0) {
    if (nt < 8) { s.kind = K_ROPE64; s.dst = big + SW_Q; s.ld = 1024; s.cbase = 0; }
    else if (nt < 10) { s.kind = K_ROPE64; s.dst = big + SW_K; s.ld = 256; s.cbase = 1024; }
    else if (nt < 12) { s.kind = K_VT; s.dst = big + SW_VT; s.cbase = 1280; s.G = 4; }
    else { s.kind = K_PLAIN; s.dst = big + SW_Z; s.ld = 1024; s.cbase = 1536; }
  } else if (mixer == 1) {
    if (nt < 3) { s.dst = big + ML_CQ; s.ld = 384; s.cbase = 0; s.stat = mstat; s.statbase = 0; }
    else if (nt < 5) { s.dst = big + ML_CKV; s.ld = 256; s.cbase = 384; s.stat = mstat; s.statbase = 6; }
    else if (nt < 13) { s.dst = big + ML_Z; s.ld = 1024; s.cbase = 640; }
    else { s.kind = K_ROPE32; s.dst = big + ML_KR; s.ld = 32; s.cbase = 1664; s.nvalid = 32; }
  } else if (mixer == 2) {
    if (nt < 8) { s.kind = K_ROPE64; s.dst = big + NS_Q; s.ld = 1024; s.cbase = 0; }
    else if (nt < 10) { s.dst = big + NS_KCR; s.ld = 256; s.cbase = 1024; }
    else if (nt < 12) { s.dst = big + NS_VCR; s.ld = 256; s.cbase = 1280; }
    else if (nt < 14) { s.kind = K_ROPE64; s.dst = big + NS_KS; s.ld = 256; s.cbase = 1536; }
    else if (nt < 16) { s.kind = K_VT; s.dst = big + NS_VST; s.cbase = 1792; }
    else if (nt < 18) { s.kind = K_ROPE64; s.dst = big + NS_KW; s.ld = 256; s.cbase = 2048; }
    else if (nt < 20) { s.kind = K_VT; s.dst = big + NS_VWT; s.cbase = 2304; }
    else if (nt < 28) { s.dst = big + NS_Z; s.ld = 1024; s.cbase = 2560; }
    else if (nt == 28) { s.dst = big + NS_GL; s.ld = 64; s.cbase = 3584; s.nvalid = 64; }
    else s.kind = K_NONE;
  } else if (mixer == 3) {
    if (nt < 8) { s.dst = big + ML_QN; s.ld = 1024; s.cbase = 0; }
    else { s.kind = K_ROPE32; s.dst = big + ML_QR; s.ld = 512; s.cbase = 1024; }
  } else if (mixer == 4) {
    if (nt < 8) { s.dst = big + ML_KN; s.ld = 1024; s.cbase = 0; }
    else { s.kind = K_VT; s.dst = big + ML_VT; s.cbase = 1024; s.G = 16; }
  } else if (mixer == 5) {
    s.dst = big + BG_PP; s.ld = 1024; s.cbase = 0;
  }
  return s;
}

DI void panel_tile(int t, int ntn, int pw, int& mt, int& nt) {
  const int per_panel = 256 * pw;
  const int p = t / per_panel;
  const int n0 = p * pw;
  const int w = (ntn - n0) < pw ? (ntn - n0) : pw;
  const int tt = t - p * per_panel;
  mt = tt / w; nt = n0 + (tt - mt * w);
}

template <bool AF32>
DI void phase_inproj_impl(const void* A, int lda, int nk, const bf16_t* Bt, int ntn, int mixer, const Params& P, unsigned char* smem, int L, int G) {
  bf16_t* big = (bf16_t*)(P.ws + OFF_BIG);
  float* mstat = (float*)(P.ws + OFF_MSTAT);
  const float2* cs64 = (const float2*)(P.ws + OFF_CS64);
  const float2* cs32 = (const float2*)(P.ws + OFF_CS32);
  const int ntiles = 256 * ntn;
  const int ldb = nk * 64;
  GR R;
  ARowPlain arb{(const bf16_t*)A, lda};
  const int pw = ntn > 5 ? 5 : ntn;
  if (L < ntiles) { int mt, nt; panel_tile(L, ntn, pw, mt, nt); gemm_first<false>(R, arb, Bt, ldb, mt * 256, nt * 256); }
  for (int t = L; t < ntiles; t += G) {
    int mt, nt; panel_tile(t, ntn, pw, mt, nt);
    f32x16 acc[4][2]; acc_zero(acc);
    const Seg sg0 = seg_for(mixer, nt * 2, big, mstat), sg1 = seg_for(mixer, nt * 2 + 1, big, mstat);
    const bool swp = seg_swapped(sg0.kind);
    gemm_loop<false>(acc, R, arb, Bt, ldb, mt * 256, nt * 256, nk, (bf16_t*)smem, swp);
    if (t + G < ntiles) { int mt2, nt2; panel_tile(t + G, ntn, pw, mt2, nt2); gemm_first<false>(R, arb, Bt, ldb, mt2 * 256, nt2 * 256); }
    __builtin_amdgcn_sched_barrier(0);
    epi_seg(acc, sg0, sg1, mt * 256, nt * 256, nullptr, cs64, cs32, (bf16_t*)smem);
  }
}

DI void phase_mla_up(const Params& P, unsigned char* smem, int L, int G) {
  bf16_t* big = (bf16_t*)(P.ws + OFF_BIG);
  const float* mstat = (const float*)(P.ws + OFF_MSTAT);
  const float2* cs64 = (const float2*)(P.ws + OFF_CS64);
  const float2* cs32 = (const float2*)(P.ws + OFF_CS32);
  float* rowA = (float*)(smem + LDS_ROW_OFF);
  const int nq = 256 * 6, nkv = 256 * 8;
  for (int t = L; t < nq + nkv; t += G) {
    const int tid = otid();
    const bool isq = t < nq;
    const int tt = isq ? t : t - nq;
    const int ntn = isq ? 6 : 8;
    const int mt = tt / ntn, nt = tt - mt * ntn;
    if (tid < 256) {
      const float* ms = mstat + (size_t)(mt * 256 + tid) * 16;
      float ssum;
      if (isq) ssum = (ms[0] + ms[1] + ms[2] + ms[3] + ms[4] + ms[5]) * (1.f / 384.f);
      else ssum = (ms[6] + ms[7] + ms[8] + ms[9]) * (1.f / 256.f);
      rowA[tid] = rsqrtf(ssum + 1e-6f);
    }
    f32x16 acc[4][2]; acc_zero(acc);
    const Seg sg0 = seg_for(isq ? 3 : 4, nt * 2, big, nullptr), sg1 = seg_for(isq ? 3 : 4, nt * 2 + 1, big, nullptr);
    const bool swp = seg_swapped(sg0.kind);
    GR R;
    if (isq) { ARowPlain ar{big + ML_CQ, 384}; gemm_first<false>(R, ar, (const bf16_t*)(P.ws + OFF_WUQT), 384, mt * 256, nt * 256); gemm_loop<false>(acc, R, ar, (const bf16_t*)(P.ws + OFF_WUQT), 384, mt * 256, nt * 256, 6, (bf16_t*)smem, swp); }
    else { ARowPlain ar{big + ML_CKV, 256}; gemm_first<false>(R, ar, (const bf16_t*)(P.ws + OFF_WUKVT), 256, mt * 256, nt * 256); gemm_loop<false>(acc, R, ar, (const bf16_t*)(P.ws + OFF_WUKVT), 256, mt * 256, nt * 256, 4, (bf16_t*)smem, swp); }
    epi_seg(acc, sg0, sg1, mt * 256, nt * 256, rowA, cs64, cs32, (bf16_t*)smem);
  }
}

DI void phase_cmp1(const Params& P, unsigned char* smem, int L, int G) {
  bf16_t* big = (bf16_t*)(P.ws + OFF_BIG);
  const float* bias = (const float*)(P.ws + OFF_BIAS);
  for (int t = L; t < 128; t += G) {
    const int which = t >> 6, mt = t & 63;
    f32x16 acc[4][2]; acc_zero(acc);
    ARowCmp ar{big + (which ? NS_VCR : NS_KCR)};
    GR R; gemm_first<false>(R, ar, (const bf16_t*)(P.ws + (which ? OFF_PV1T : OFF_PK1T)), 2048, mt * 256, 0);
    gemm_loop<false>(acc, R, ar, (const bf16_t*)(P.ws + (which ? OFF_PV1T : OFF_PK1T)), 2048, mt * 256, 0, 32, (bf16_t*)smem, true);
    Seg s; s.kind = K_SILU; s.dst = big + (which ? NS_HV : NS_HK); s.ld = 256; s.cbase = 0; s.G = 4; s.nvalid = 1 << 30; s.stat = nullptr; s.statbase = 0;
    s.bias = bias + which * 256;
    epi_seg(acc, s, s, mt * 256, 0, nullptr, nullptr, nullptr, (bf16_t*)smem);
  }
}
DI void phase_cmp2(const Params& P, unsigned char* smem, int L, int G) {
  bf16_t* big = (bf16_t*)(P.ws + OFF_BIG);
  const float2* cs64 = (const float2*)(P.ws + OFF_CS64);
  for (int t = L; t < 128; t += G) {
    const int which = t >> 6, mt = t & 63;
    f32x16 acc[4][2]; acc_zero(acc);
    ARowPlain ar{big + (which ? NS_HV : NS_HK), 256};
    GR R; gemm_first<false>(R, ar, (const bf16_t*)(P.ws + (which ? OFF_PV2T : OFF_PK2T)), 256, mt * 256, 0);
    gemm_loop<false>(acc, R, ar, (const bf16_t*)(P.ws + (which ? OFF_PV2T : OFF_PK2T)), 256, mt * 256, 0, 4, (bf16_t*)smem, !which);
    Seg s; s.kind = which ? K_VCT : K_KC2; s.dst = big + (which ? NS_VCT : NS_KC2); s.ld = 64; s.cbase = 0; s.G = 4; s.nvalid = 64; s.stat = nullptr; s.statbase = 0; s.bias = nullptr;
    Seg none = s; none.kind = K_NONE;
    epi_seg(acc, s, none, mt * 256, 0, nullptr, cs64, nullptr, (bf16_t*)smem);
  }
}

DI void attn_write_staged(const f32x16& o0, const f32x16& o1, bf16_t* og, const bf16_t* z, size_t tok0, int head, int lane, bf16_t* wl) {
  const int q = lane & 31, h = lane >> 5;
#pragma unroll
  for (int dt = 0; dt < 2; ++dt)
#pragma unroll
    for (int q4 = 0; q4 < 4; ++q4) {
      const f32x16& o = dt ? o1 : o0;
      *(uint2*)(wl + q * 72 + dt * 32 + 8 * q4 + 4 * h) = make_uint2(pack2(o[4 * q4], o[4 * q4 + 1]), pack2(o[4 * q4 + 2], o[4 * q4 + 3]));
    }
#pragma unroll
  for (int k = 0; k < 4; ++k) {
    const int ci = lane + 64 * k, row = ci >> 3, c8 = ci & 7;
    const u32x4 ov = *(const u32x4*)(wl + row * 72 + c8 * 8);
    const size_t off = (tok0 + row) * 1024 + head * 64 + c8 * 8;
    const u32x4 zv = ldg16(z + off);
    u32x4 r;
    r.x = pack2(bflo(ov.x) * siluf_(bflo(zv.x)), bfhi(ov.x) * siluf_(bfhi(zv.x)));
    r.y = pack2(bflo(ov.y) * siluf_(bflo(zv.y)), bfhi(ov.y) * siluf_(bfhi(zv.y)));
    r.z = pack2(bflo(ov.z) * siluf_(bflo(zv.z)), bfhi(ov.z) * siluf_(bfhi(zv.z)));
    r.w = pack2(bflo(ov.w) * siluf_(bflo(zv.w)), bfhi(ov.w) * siluf_(bfhi(zv.w)));
    *(u32x4*)(og + off) = r;
  }
}
DI void attn_write(const f32x16& o0, const f32x16& o1, bf16_t* og, const bf16_t* z, size_t tok, int head, int h) {
#pragma unroll
  for (int dt = 0; dt < 2; ++dt)
#pragma unroll
    for (int q4 = 0; q4 < 4; ++q4) {
      const int d = dt * 32 + 8 * q4 + 4 * h;
      const size_t off = tok * 1024 + head * 64 + d;
      const uint2 zz = *(const uint2*)(z + off);
      const f32x16& o = dt ? o1 : o0;
      uint2 pk;
      pk.x = pack2(o[4 * q4] * siluf_(bflo(zz.x)), o[4 * q4 + 1] * siluf_(bfhi(zz.x)));
      pk.y = pack2(o[4 * q4 + 2] * siluf_(bflo(zz.y)), o[4 * q4 + 3] * siluf_(bfhi(zz.y)));
      *(uint2*)(og + off) = pk;
    }
}

DI void gqa_item(int p, int L, int G, int gi, int& qt, int& bg) {
  if (G == 256) { const int x = L >> 5, lb = L & 31, k = p >> 8; bg = x * 16 + (k & ~1) + gi; qt = (k & 1) ? 63 - lb : lb; }
  else { qt = 63 - (p >> 6); bg = (p & 63) * 2 + gi; }
}
DI void mla_item(int p, int L, int G, int gi, int& qt, int& bh) {
  if (G == 256) { const int x = L >> 5, lb = L & 31, k = p >> 8; bh = x * 64 + k * 4 + (lb >> 4) * 2 + gi; qt = (k & 1) ? 15 - (lb & 15) : (lb & 15); }
  else { qt = 15 - (p >> 8); bh = (p & 255) * 2 + gi; }
}

DI void phase_attn_swa(const Params& P, const float* sinks, bf16_t* og, unsigned char* smem, int L, int G) {
  bf16_t* big = (bf16_t*)(P.ws + OFF_BIG);
  const int tid0 = otid(), gi = tid0 >> 8, tid = tid0 & 255, lane = tid & 63, w = tid >> 6, r = lane & 31, h = lane >> 5;
  smem += gi * ATT_LDS;
  bf16_t* sK = (bf16_t*)smem; bf16_t* sVt = sK + 64 * 72;
  const float sc = 0.125f * LOG2E;
  for (int it = L; it < 4096; it += G) {
    int qt, bg; gqa_item(it, L, G, gi, qt, bg);
    const int b = bg >> 2, g = bg & 3;
    const int t0 = qt * 32, t = t0 + r, head = g * 4 + w;
    const size_t tok = (size_t)b * SEQ + t;
    bf16x8 qf[4];
#pragma unroll
    for (int ks = 0; ks < 4; ++ks) qf[ks] = *(const bf16x8*)(big + SW_Q + tok * 1024 + head * 64 + ks * 16 + 8 * h);
    f32x16 o0, o1, s[2]; o_zero(o0, o1);
    float m = sinks[head] * LOG2E, l = 1.f;
    const bf16_t* kb = big + SW_K + (size_t)b * SEQ * 256 + g * 64;
    const bf16_t* vb = big + SW_VT + (size_t)((b * 4 + g) * 64) * SEQ;
    const int jlo = (t0 - 127 > 0 ? t0 - 127 : 0) >> 6, jhi = (t0 + 31) >> 6;
    KVR R; kv64_fetch(R, kb, 256, vb, SEQ, jlo * 64, true, tid);
    __syncthreads();
    kv64_store(R, sK, sVt, tid);
    if (jlo < jhi) kv64_fetch(R, kb, 256, vb, SEQ, jlo * 64 + 64, true, tid);
    for (int j = jlo; j <= jhi; ++j) {
      const int key0 = j * 64, cb = (j - jlo) & 1;
      __syncthreads();
      if (j < jhi) kv64_store(R, sK + (cb ^ 1) * KVB64, sVt + (cb ^ 1) * KVB64, tid);
      if (j + 1 < jhi) kv64_fetch(R, kb, 256, vb, SEQ, key0 + 128, true, tid);
      __builtin_amdgcn_sched_barrier(0);
      auto mf = [&](int kk) { const int key = key0 + kk; return key <= t && key > t - 128; };
      attn_step<64, true, 0>(sK + cb * KVB64, sVt + cb * KVB64, qf, o0, o1, m, l, sc, mf, lane, s, 0.f);
    }
    const float il = 1.f / l;
#pragma unroll
    for (int q = 0; q < 16; ++q) { o0[q] *= il; o1[q] *= il; }
    attn_write_staged(o0, o1, og, big + SW_Z, (size_t)b * SEQ + t0, head, lane, (bf16_t*)(smem + 40960) + w * (32 * 72));
  }
}

struct KVR8 { u32x4 k0, k2, v0; };
DI void kv96x8_fetch(KVR8& R, const bf16_t* knbase, const bf16_t* krbase, const bf16_t* vtbase, int key0, int tid) {
  const int row = tid >> 3, kc = tid & 7, rr = (tid & 255) >> 2, rc = tid & 3;
  R.k0 = ldg16(knbase + (size_t)(key0 + row) * 1024 + kc * 8);
  R.k2 = ldg16(krbase + (size_t)(key0 + rr) * 32 + rc * 8);
  R.v0 = ldg16(vtbase + (size_t)row * SEQ + key0 + kc * 8);
}
DI void kv96x8_store(const KVR8& R, bf16_t* sK, bf16_t* sVt, int tid) {
  const int row = tid >> 3, kc = tid & 7, rr = (tid & 255) >> 2, rc = tid & 3;
  *(u32x4*)(sK + row * 104 + kc * 8) = R.k0;
  if (tid < 256) *(u32x4*)(sK + rr * 104 + 64 + rc * 8) = R.k2;
  *(u32x4*)(sVt + row * 72 + kc * 8) = R.v0;
}
DI void mla_item8(int p, int L, int G, int& qt, int& bh) {
  if (G == 256) { const int x = L >> 5, lb = L & 31, k = p >> 8; bh = x * 64 + k * 4 + (lb >> 3); qt = (k & 1) ? 7 - (lb & 7) : (lb & 7); }
  else { qt = 7 - (p >> 9); bh = p & 511; }
}
DI void phase_attn_mla(const Params& P, bf16_t* og, unsigned char* smem, int L, int G) {
  bf16_t* big = (bf16_t*)(P.ws + OFF_BIG);
  const int tid = otid(), lane = tid & 63, w = tid >> 6, r = lane & 31, h = lane >> 5;
  bf16_t* sK = (bf16_t*)smem; bf16_t* sVt = sK + 64 * 104;
  const float sc = 0.10206207261596575f * LOG2E;
  for (int it = L; it < 4096; it += G) {
    int qt, bh; mla_item8(it, L, G, qt, bh);
    const int b = bh >> 4, head = bh & 15;
    const int t0 = qt * 256 + w * 32, t = t0 + r;
    const size_t tok = (size_t)b * SEQ + t;
    bf16x8 qf[6];
#pragma unroll
    for (int ks = 0; ks < 4; ++ks) qf[ks] = *(const bf16x8*)(big + ML_QN + tok * 1024 + head * 64 + ks * 16 + 8 * h);
#pragma unroll
    for (int ks = 0; ks < 2; ++ks) qf[4 + ks] = *(const bf16x8*)(big + ML_QR + tok * 512 + head * 32 + ks * 16 + 8 * h);
    f32x16 o0, o1, s[2]; o_zero(o0, o1);
    float m = NEGF, l = 0.f;
    const bf16_t* knb = big + ML_KN + (size_t)b * SEQ * 1024 + head * 64;
    const bf16_t* krb = big + ML_KR + (size_t)b * SEQ * 32;
    const bf16_t* vb = big + ML_VT + (size_t)((b * 16 + head) * 64) * SEQ;
    const int jhi = (qt * 256 + 255) >> 6;
    KVR8 R; kv96x8_fetch(R, knb, krb, vb, 0, tid);
    __syncthreads();
    kv96x8_store(R, sK, sVt, tid);
    if (0 < jhi) kv96x8_fetch(R, knb, krb, vb, 64, tid);
    for (int j = 0; j <= jhi; ++j) {
      const int key0 = j * 64, cb = j & 1;
      __syncthreads();
      if (j < jhi) kv96x8_store(R, sK + (cb ^ 1) * KVB96, sVt + (cb ^ 1) * KVB96, tid);
      if (j + 1 < jhi) kv96x8_fetch(R, knb, krb, vb, key0 + 128, tid);
      __builtin_amdgcn_sched_barrier(0);
      if (key0 <= t0 + 31) {
        auto mf = [&](int kk) { return key0 + kk <= t; };
        if (key0 + 63 > t0) attn_step<96, true, 0>(sK + cb * KVB96, sVt + cb * KVB96, qf, o0, o1, m, l, sc, mf, lane, s, 0.f);
        else attn_step<96, false, 0>(sK + cb * KVB96, sVt + cb * KVB96, qf, o0, o1, m, l, sc, mf, lane, s, 0.f);
      }
    }
    const float il = 1.f / l;
#pragma unroll
    for (int q = 0; q < 16; ++q) { o0[q] *= il; o1[q] *= il; }
    attn_write_staged(o0, o1, og, big + ML_Z, (size_t)b * SEQ + t0, head, lane, (bf16_t*)(smem + 49152) + w * (32 * 72));
  }
}

DI void tot_store(float* totL, int tid, const f32x16& a, const f32x16& b, float gi) {
#pragma unroll
  for (int k = 0; k < 4; ++k) {
    f32x4 v0 = {a[4 * k] * gi, a[4 * k + 1] * gi, a[4 * k + 2] * gi, a[4 * k + 3] * gi};
    f32x4 v1 = {b[4 * k] * gi, b[4 * k + 1] * gi, b[4 * k + 2] * gi, b[4 * k + 3] * gi};
    *(f32x4*)(totL + ((size_t)(k * 256 + tid)) * 4) = v0;
    *(f32x4*)(totL + ((size_t)((4 + k) * 256 + tid)) * 4) = v1;
  }
}
DI void tot_addto(float* totL, int tid, f32x16& a, f32x16& b, float gi) {
#pragma unroll
  for (int k = 0; k < 4; ++k) {
    const f32x4 v0 = *(const f32x4*)(totL + ((size_t)(k * 256 + tid)) * 4);
    const f32x4 v1 = *(const f32x4*)(totL + ((size_t)((4 + k) * 256 + tid)) * 4);
    a[4 * k] = v0.x + gi * a[4 * k]; a[4 * k + 1] = v0.y + gi * a[4 * k + 1]; a[4 * k + 2] = v0.z + gi * a[4 * k + 2]; a[4 * k + 3] = v0.w + gi * a[4 * k + 3];
    b[4 * k] = v1.x + gi * b[4 * k]; b[4 * k + 1] = v1.y + gi * b[4 * k + 1]; b[4 * k + 2] = v1.z + gi * b[4 * k + 2]; b[4 * k + 3] = v1.w + gi * b[4 * k + 3];
  }
}
DI void phase_attn_nsa(const Params& P, bf16_t* og, unsigned char* smem, int L, int G) {
  bf16_t* big = (bf16_t*)(P.ws + OFF_BIG);
  const int gi = otid() >> 8;
  smem += gi * ATT_LDS;
  bf16_t* sK = (bf16_t*)smem; bf16_t* sVt = sK + 64 * 72;
  float* impL = (float*)(smem + 37376);
  float* scoreL = impL + 4 * 32 * 33;
  unsigned* selL = (unsigned*)(smem + 36864);
  float* totL = (float*)(smem + 37376);
  const float sc = 0.125f * LOG2E;
  for (int it = L; it < 4096; it += G) {
    int tid = threadIdx.x;
    asm volatile("" : "+v"(tid));
    tid &= 255;
    const int lane = tid & 63, w = tid >> 6, r = lane & 31, h = lane >> 5;
    int qt, bg; gqa_item(it, L, G, gi, qt, bg);
    const int b = bg >> 2, g = bg & 3;
    const int t0 = qt * 32, t = t0 + r, head = g * 4 + w;
    const size_t tok = (size_t)b * SEQ + t;
    bf16x8 qf[4];
#pragma unroll
    for (int ks = 0; ks < 4; ++ks) qf[ks] = *(const bf16x8*)(big + NS_Q + tok * 1024 + head * 64 + ks * 16 + 8 * h);
    const bf16_t* glp = big + NS_GL + tok * 64;
    const float g0 = sigmoidf_(bf2f(glp[head])), g1 = sigmoidf_(bf2f(glp[16 + head])), g2 = sigmoidf_(bf2f(glp[32 + head]));
    f32x16 o0, o1, s[2];
    {
      const bf16_t* kb = big + NS_KC2 + (size_t)((b * 4 + g) * 128) * 64;
      const bf16_t* vb = big + NS_VCT + (size_t)((b * 4 + g) * 64) * 128;
      float m = NEGF, l = 0.f;
      KVR R; kv64_fetch(R, kb, 64, vb, 128, 0, false, tid);
#pragma unroll
      for (int tile = 0; tile < 2; ++tile) {
        const int key0 = tile * 64;
        kv64_commit(R, sK, sVt, false, tid);
        if (tile == 0) kv64_fetch(R, kb, 64, vb, 128, 64, false, tid); else kv64_fetch(R, kb, 64, vb, 128, 0, true, tid);
        __builtin_amdgcn_sched_barrier(0);
        auto mf = [&](int kk) { return (key0 + kk) * 16 + 31 <= t; };
        attn_step<64, true, 1>(sK, sVt, qf, o0, o1, m, l, sc, mf, lane, s, 0.f);
      }
      const float invl = l > 0.f ? 1.f / l : 0.f;
      o_zero(o0, o1);
      float cprev = 0.f;
#pragma unroll
      for (int tile = 0; tile < 2; ++tile) {
        const int key0 = tile * 64;
        kv64_commit(R, sK, sVt, true, tid);
        if (tile == 0) kv64_fetch(R, kb, 64, vb, 128, 64, true, tid);
        __builtin_amdgcn_sched_barrier(0);
        auto mf = [&](int kk) { return (key0 + kk) * 16 + 31 <= t; };
        float l2 = 0.f;
        attn_step<64, true, 2>(sK, sVt, qf, o0, o1, m, l2, sc, mf, lane, s, invl);
#pragma unroll
        for (int sub = 0; sub < 2; ++sub)
#pragma unroll
          for (int s2 = 0; s2 < 2; ++s2) {
            const int Gi = tile * 4 + sub * 2 + s2;
            const int q0 = 8 * s2;
            const float Aj = s[sub][q0] + s[sub][q0 + 1] + s[sub][q0 + 2] + s[sub][q0 + 3];
            const float Bj = s[sub][q0 + 4] + s[sub][q0 + 5] + s[sub][q0 + 6] + s[sub][q0 + 7] + s[sub][q0 + 3];
            const float cx = shx(s[sub][q0 + 7], 32);
            const float add = h ? cx : cprev;
            cprev = cx;
            impL[(w * 32 + r) * 33 + 4 * Gi + 2 * h] = Aj + add;
            impL[(w * 32 + r) * 33 + 4 * Gi + 2 * h + 1] = Bj;
          }
      }
    }
    __syncthreads();
#pragma unroll
    for (int pss = 0; pss < 4; ++pss) {
      const int pair = pss * 256 + tid, q = pair >> 5, j = pair & 31;
      scoreL[q * 33 + j] = impL[(0 * 32 + q) * 33 + j] + impL[(1 * 32 + q) * 33 + j] + impL[(2 * 32 + q) * 33 + j] + impL[(3 * 32 + q) * 33 + j];
    }
    __syncthreads();
#pragma unroll
    for (int pss = 0; pss < 4; ++pss) {
      const int pair = pss * 256 + tid, q = pair >> 5, j = pair & 31;
      const int tq = t0 + q, cur = tq >> 6;
      const bool forced = (j == 0) || (j == cur) || (j == cur - 1);
      const int nf = cur >= 2 ? 3 : cur + 1;
      const int need = 8 - nf;
      const bool cand = (j >= 1) && (j <= cur - 2);
      const float sj = scoreL[q * 33 + j];
      int rank = 0;
      for (int j2 = 1; j2 <= cur - 2; ++j2) {
        const float s2v = scoreL[q * 33 + j2];
        rank += (s2v > sj || (s2v == sj && j2 < j)) ? 1 : 0;
      }
      const bool selected = forced || (cand && rank < need);
      const unsigned long long bal = __ballot(selected);
      if (j == 0) selL[q] = (unsigned)(bal >> (32 * (lane >> 5)));
    }
    __syncthreads();
    const unsigned sel = selL[r];
    unsigned selU = sel;
    selU |= (unsigned)__shfl_xor((int)selU, 1, 64); selU |= (unsigned)__shfl_xor((int)selU, 2, 64); selU |= (unsigned)__shfl_xor((int)selU, 4, 64);
    selU |= (unsigned)__shfl_xor((int)selU, 8, 64); selU |= (unsigned)__shfl_xor((int)selU, 16, 64);
    selU = (unsigned)__builtin_amdgcn_readfirstlane((int)selU);
    tot_store(totL, tid, o0, o1, g0);
    {
      const bf16_t* kb = big + NS_KS + (size_t)b * SEQ * 256 + g * 64;
      const bf16_t* vb = big + NS_VST + (size_t)((b * 4 + g) * 64) * SEQ;
      float m = NEGF, l = 0.f; o_zero(o0, o1);
      const int jhi = (t0 + 31) >> 6;
      KVR R; kv64_fetch(R, kb, 256, vb, SEQ, 0, true, tid);
      __syncthreads();
      kv64_store(R, sK, sVt, tid);
      if (0 < jhi) kv64_fetch(R, kb, 256, vb, SEQ, 64, true, tid);
      for (int j = 0; j <= jhi; ++j) {
        const int key0 = j * 64, cb = j & 1;
        __syncthreads();
        if (j < jhi) kv64_store(R, sK + (cb ^ 1) * KVB64, sVt + (cb ^ 1) * KVB64, tid);
        if (j + 1 < jhi) kv64_fetch(R, kb, 256, vb, SEQ, key0 + 128, true, tid);
        __builtin_amdgcn_sched_barrier(0);
        if ((selU >> j) & 1u) {
          const bool lsel = (sel >> j) & 1u;
          auto mf = [&](int kk) { return lsel && (key0 + kk <= t); };
          if (key0 + 63 > t0) attn_step<64, true, 0>(sK + cb * KVB64, sVt + cb * KVB64, qf, o0, o1, m, l, sc, mf, lane, s, 0.f);
          else attn_step<64, false, 0>(sK + cb * KVB64, sVt + cb * KVB64, qf, o0, o1, m, l, sc, mf, lane, s, 0.f, lsel);
        }
      }
      tot_addto(totL, tid, o0, o1, g1 / l);
      tot_store(totL, tid, o0, o1, 1.f);
    }
    {
      const bf16_t* kb = big + NS_KW + (size_t)b * SEQ * 256 + g * 64;
      const bf16_t* vb = big + NS_VWT + (size_t)((b * 4 + g) * 64) * SEQ;
      float m = NEGF, l = 0.f; o_zero(o0, o1);
      const int jlo = (t0 - 511 > 0 ? t0 - 511 : 0) >> 6, jhi = (t0 + 31) >> 6;
      KVR R; kv64_fetch(R, kb, 256, vb, SEQ, jlo * 64, true, tid);
      __syncthreads();
      kv64_store(R, sK, sVt, tid);
      if (jlo < jhi) kv64_fetch(R, kb, 256, vb, SEQ, jlo * 64 + 64, true, tid);
      for (int j = jlo; j <= jhi; ++j) {
        const int key0 = j * 64, cb = (j - jlo) & 1;
        __syncthreads();
        if (j < jhi) kv64_store(R, sK + (cb ^ 1) * KVB64, sVt + (cb ^ 1) * KVB64, tid);
        if (j + 1 < jhi) kv64_fetch(R, kb, 256, vb, SEQ, key0 + 128, true, tid);
        __builtin_amdgcn_sched_barrier(0);
        auto mf = [&](int kk) { const int key = key0 + kk; return key <= t && key > t - 512; };
        if (key0 + 63 > t0 || key0 <= t0 + 31 - 512) attn_step<64, true, 0>(sK + cb * KVB64, sVt + cb * KVB64, qf, o0, o1, m, l, sc, mf, lane, s, 0.f);
        else attn_step<64, false, 0>(sK + cb * KVB64, sVt + cb * KVB64, qf, o0, o1, m, l, sc, mf, lane, s, 0.f);
      }
      tot_addto(totL, tid, o0, o1, g2 / l);
    }
    __syncthreads();
    attn_write_staged(o0, o1, og, big + NS_Z, (size_t)b * SEQ + t0, head, lane, sK + w * (32 * 72));
    __syncthreads();
  }
}

template <bool XF32>
DI void phase_outproj(const Params& P, int layer, const void* xres, const bf16_t* og, unsigned char* smem, int L, int G) {
  bf16_t* Sb = (bf16_t*)(P.ws + OFF_BIG);
  float* stats = (float*)(P.ws + OFF_STATS);
  const bf16_t* Bt = (const bf16_t*)(P.ws + OFF_WOUTT) + (size_t)layer * 1024 * 1024;
  bf16_t* stg = (bf16_t*)smem;
  GR R;
  ARowPlain ar{og, 1024};
  if (L < 256 * 4) gemm_first<false>(R, ar, Bt, 1024, (L >> 2) * 256, (L & 3) * 256);
  for (int t = L; t < 256 * 4; t += G) {
    const int mt = t >> 2, nt = t & 3;
    const int tid = otid();
    const int lane = tid & 63, w = tid >> 6, r = lane & 31, h = lane >> 5;
    const int wm = w >> 2, wn = w & 3;
    f32x16 acc[4][2]; acc_zero(acc);
    gemm_loop<false>(acc, R, ar, Bt, 1024, mt * 256, nt * 256, 16, (bf16_t*)smem, true);
    if (t + G < 256 * 4) gemm_first<false>(R, ar, Bt, 1024, ((t + G) >> 2) * 256, ((t + G) & 3) * 256);
    __builtin_amdgcn_sched_barrier(0);
    stage_load_tile<true>(stg, (const bf16_t*)xres + (size_t)mt * 256 * 1024 + nt * 256);
    __syncthreads();
#pragma unroll
    for (int j = 0; j < 2; ++j)
#pragma unroll
      for (int ch = 0; ch < 2; ++ch) {
        float s1 = 0.f, s2 = 0.f;
#pragma unroll
        for (int i = 2 * ch; i < 2 * ch + 2; ++i)
#pragma unroll
          for (int q4 = 0; q4 < 4; ++q4) {
            uint2* pp = (uint2*)(stg + (wn * 64 + j * 32 + r) * STG + wm * 128 + i * 32 + 8 * q4 + 4 * h);
            const uint2 xv = *pp;
            uint2 pk;
            pk.x = pack2(DN_ALPHA * bflo(xv.x) + acc[i][j][4 * q4], DN_ALPHA * bfhi(xv.x) + acc[i][j][4 * q4 + 1]);
            pk.y = pack2(DN_ALPHA * bflo(xv.y) + acc[i][j][4 * q4 + 2], DN_ALPHA * bfhi(xv.y) + acc[i][j][4 * q4 + 3]);
            *pp = pk;
            const float f0 = bflo(pk.x), f1 = bfhi(pk.x), f2 = bflo(pk.y), f3 = bfhi(pk.y);
            s1 += (f0 + f1) + (f2 + f3); s2 += (f0 * f0 + f1 * f1) + (f2 * f2 + f3 * f3);
            __builtin_amdgcn_sched_barrier(0);
          }
        s1 += shx(s1, 32); s2 += shx(s2, 32);
        if (h == 0) {
          const size_t row = (size_t)(mt * 256 + wn * 64 + j * 32 + r);
          *(float2*)(stats + row * 32 + (nt * 4 + wm * 2 + ch) * 2) = make_float2(s1, s2);
        }
      }
    __syncthreads();
    stage_store_tile(stg, Sb + (size_t)mt * 256 * 1024 + nt * 256);
    __syncthreads();
  }
}

template <bool LAST>
DI void phase_gate(const Params& P, int layer, unsigned char* smem, int L, int G) {
  const bf16_t* Sb = (const bf16_t*)(P.ws + OFF_BIG);
  const bf16_t* PPb = (const bf16_t*)(P.ws + OFF_BIG) + BG_PP;
  const float* stats = (const float*)(P.ws + OFF_STATS);
  const bf16_t* Bg = (const bf16_t*)(P.ws + OFF_PGT) + (size_t)layer * 1024 * 1024;
  const float* c1 = (const float*)(P.ws + OFF_C1) + layer * 1024;
  const float* c2 = (const float*)(P.ws + OFF_C2) + layer * 1024;
  const float* lg = P.ln_g + layer * 1024; const float* lb = P.ln_b + layer * 1024;
  bf16_t* xb = (bf16_t*)(P.ws + OFF_XB);
  float* rowA = (float*)(smem + LDS_ROW_OFF); float* rowB = rowA + 256;
  float* vecL = (float*)(smem + LDS_VEC_OFF);
  bf16_t* stg = (bf16_t*)smem;
  GR R;
  ARowPlain ars{Sb, 1024};
  for (int t = L; t < 256 * 4; t += G) {
    const int mt = t >> 2, nt = t & 3;
    const int tid = otid();
    const int lane = tid & 63, w = tid >> 6, r = lane & 31, h = lane >> 5;
    const int wm = w >> 2, wn = w & 3;
    if (tid < 256) {
      const f32x4* st = (const f32x4*)(stats + (size_t)(mt * 256 + tid) * 32);
      float a = 0.f, b2 = 0.f;
#pragma unroll
      for (int q = 0; q < 8; ++q) { const f32x4 v = st[q]; a += v.x + v.z; b2 += v.y + v.w; }
      const float mu = a * (1.f / 1024.f);
      const float var = b2 * (1.f / 1024.f) - mu * mu;
      rowA[tid] = mu; rowB[tid] = rsqrtf(fmaxf(var, 0.f) + 1e-5f);
      vecL[tid] = c1[nt * 256 + tid]; vecL[256 + tid] = c2[nt * 256 + tid]; vecL[512 + tid] = lg[nt * 256 + tid]; vecL[768 + tid] = lb[nt * 256 + tid];
    }
    f32x16 accu[4][2]; acc_zero(accu);
    if (t == L) gemm_first<false>(R, ars, Bg, 1024, mt * 256, nt * 256);
    gemm_loop<false>(accu, R, ars, Bg, 1024, mt * 256, nt * 256, 16, (bf16_t*)smem, true);
    if (t + G < 256 * 4) gemm_first<false>(R, ars, Bg, 1024, ((t + G) >> 2) * 256, ((t + G) & 3) * 256);
    __builtin_amdgcn_sched_barrier(0);
    unsigned gq[4][2][8];
#pragma unroll
    for (int i = 0; i < 4; ++i)
#pragma unroll
      for (int q4 = 0; q4 < 4; ++q4) {
        const int fl = wm * 128 + i * 32 + 8 * q4 + 4 * h;
        const f32x4 c1v = *(const f32x4*)(vecL + fl), c2v = *(const f32x4*)(vecL + 256 + fl);
        const float c1a[4] = {c1v.x, c1v.y, c1v.z, c1v.w}, c2a[4] = {c2v.x, c2v.y, c2v.z, c2v.w};
#pragma unroll
        for (int j = 0; j < 2; ++j) {
          const int lrow = wn * 64 + j * 32 + r;
          const float mu = rowA[lrow], rstd = rowB[lrow];
          float sg4[4];
#pragma unroll
          for (int e = 0; e < 4; ++e) sg4[e] = sigmoidf_(rstd * (accu[i][j][4 * q4 + e] - mu * c1a[e]) + c2a[e]);
          gq[i][j][2 * q4] = pack2(sg4[0], sg4[1]); gq[i][j][2 * q4 + 1] = pack2(sg4[2], sg4[3]);
        }
        __builtin_amdgcn_sched_barrier(0);
      }
    stage_load_tile<true>(stg, PPb + (size_t)mt * 256 * 1024 + nt * 256);
    __syncthreads();
    {
      const int tid1 = otid();
      const int lane1 = tid1 & 63, w1 = tid1 >> 6, r1 = lane1 & 31, h1 = lane1 >> 5, wm1 = w1 >> 2, wn1 = w1 & 3;
#pragma unroll
      for (int i = 0; i < 4; ++i)
#pragma unroll
        for (int q4 = 0; q4 < 4; ++q4) {
#pragma unroll
          for (int j = 0; j < 2; ++j) {
            const uint2 pv = *(const uint2*)(stg + (wn1 * 64 + j * 32 + r1) * STG + wm1 * 128 + i * 32 + 8 * q4 + 4 * h1);
            const unsigned g0 = gq[i][j][2 * q4], g1 = gq[i][j][2 * q4 + 1];
            gq[i][j][2 * q4] = pack2(bflo(g0) * bflo(pv.x), bfhi(g0) * bfhi(pv.x));
            gq[i][j][2 * q4 + 1] = pack2(bflo(g1) * bflo(pv.y), bfhi(g1) * bfhi(pv.y));
          }
          __builtin_amdgcn_sched_barrier(0);
        }
    }
    __syncthreads();
    stage_load_tile<false>(stg, Sb + (size_t)mt * 256 * 1024 + nt * 256);
    __syncthreads();
    const int tid2 = otid();
    const int lane2 = tid2 & 63, w2 = tid2 >> 6, r2 = lane2 & 31, h2 = lane2 >> 5, wm2 = w2 >> 2, wn2 = w2 & 3;
#pragma unroll
    for (int i = 0; i < 4; ++i)
#pragma unroll
      for (int q4 = 0; q4 < 4; ++q4) {
        const int fl = wm2 * 128 + i * 32 + 8 * q4 + 4 * h2;
        const int f0 = nt * 256 + fl;
        const f32x4 gv = *(const f32x4*)(vecL + 512 + fl), bv = *(const f32x4*)(vecL + 768 + fl);
        const float ga[4] = {gv.x, gv.y, gv.z, gv.w}, ba[4] = {bv.x, bv.y, bv.z, bv.w};
#pragma unroll
        for (int j = 0; j < 2; ++j) {
          const int lrow = wn2 * 64 + j * 32 + r2;
          const float mu = rowA[lrow], rstd = rowB[lrow];
          uint2* sp = (uint2*)(stg + lrow * STG + fl);
          const uint2 sv = *sp;
          const float sa[4] = {bflo(sv.x), bfhi(sv.x), bflo(sv.y), bfhi(sv.y)};
          float y[4];
          const float gg[4] = {bflo(gq[i][j][2 * q4]), bfhi(gq[i][j][2 * q4]), bflo(gq[i][j][2 * q4 + 1]), bfhi(gq[i][j][2 * q4 + 1])};
#pragma unroll
          for (int e = 0; e < 4; ++e) y[e] = (sa[e] - mu) * rstd * ga[e] + ba[e] + gg[e];
          if (LAST) { f32x4 o = {y[0], y[1], y[2], y[3]}; *(f32x4*)(P.out + (size_t)(mt * 256 + lrow) * 1024 + f0) = o; }
          else { uint2 pk; pk.x = pack2(y[0], y[1]); pk.y = pack2(y[2], y[3]); *sp = pk; }
        }
        __builtin_amdgcn_sched_barrier(0);
      }
    __syncthreads();
    if (!LAST) stage_store_tile(stg, xb + (size_t)mt * 256 * 1024 + nt * 256);
    __syncthreads();
  }
}

#define XB_TMO      128
#define XB_XCNT(j)  (256  + 64 * (j))
#define XB_XSUB(j)  (1280 + 64 * (j))
#define XB_XGEN(j)  (2304 + 64 * (j))
#define XB_TOP      3328
#define XB_TOPGEN   3392
#define XCD_BAR_WORDS 3456
#define XB_SPIN_CAP (1u << 22)
#define LAS __attribute__((address_space(3)))
DI unsigned xb_ld(unsigned* p) { return __hip_atomic_load(p, __ATOMIC_RELAXED, __HIP_MEMORY_SCOPE_AGENT); }
DI unsigned xb_add(unsigned* p, unsigned v) { return __hip_atomic_fetch_add(p, v, __ATOMIC_RELAXED, __HIP_MEMORY_SCOPE_AGENT); }
DI unsigned xb_xcc_id() { return (unsigned)__builtin_amdgcn_s_getreg((3 << 11) | 20) & 0xFu; }
#define XB_SPIN(cond, bar) do { unsigned _sp = 0; while (cond) { __builtin_amdgcn_s_sleep(1); \
    if ((++_sp & 255u) == 0u) { if (xb_ld(&(bar)[XB_TMO])) break; if (_sp > XB_SPIN_CAP) { atomicAdd(&(bar)[XB_TMO], 1u); break; } } } } while (0)
struct XcdBarrier { unsigned* bar; unsigned x; volatile LAS unsigned* st; };
DI XcdBarrier xcd_barrier_post(unsigned* bar, volatile LAS unsigned* st) {
  XcdBarrier b; b.bar = bar; b.x = xb_xcc_id(); b.st = st;
  if (threadIdx.x == 0) (void)xb_add(&bar[XB_XCNT(b.x)], 1u);
  return b;
}
DI void xcd_barrier_complete(unsigned* bar, unsigned x, unsigned& nloc, unsigned& nx) {
  const unsigned G = gridDim.x * gridDim.y * gridDim.z;
  unsigned sum, cnt, mine, sp = 0u;
  for (;;) {
    sum = 0u; cnt = 0u; mine = 0u;
#pragma unroll
    for (unsigned j = 0; j < 16; ++j) { const unsigned c = xb_ld(&bar[XB_XCNT(j)]); sum += c; cnt += (c > 0u) ? 1u : 0u; mine = (j == x) ? c : mine; }
    if (sum == G) break;
    __builtin_amdgcn_s_sleep(1);
    if ((++sp & 255u) == 0u) { if (xb_ld(&bar[XB_TMO])) break; if (sp > XB_SPIN_CAP) { atomicAdd(&bar[XB_TMO], 1u); break; } }
  }
  nloc = mine > 0u ? mine : 1u; nx = cnt > 0u ? cnt : 1u;
}
DI void xcd_barrier(const XcdBarrier& b) {
  asm volatile("s_waitcnt vmcnt(0)" ::: "memory");
  __syncthreads();
  if (threadIdx.x == 0) {
    unsigned* bar = b.bar;
    __builtin_amdgcn_s_waitcnt(0);
    unsigned nloc = b.st[0], nx = b.st[1];
    if (nloc == 0u) { xcd_barrier_complete(bar, b.x, nloc, nx); b.st[0] = nloc; b.st[1] = nx; }
    const unsigned old = xb_add(&bar[XB_XSUB(b.x)], 1u);
    const unsigned gen = old / nloc;
    if (old + 1u == (gen + 1u) * nloc) {
      __builtin_amdgcn_fence(__ATOMIC_RELEASE, "agent");
      asm volatile("s_waitcnt vmcnt(0)" ::: "memory");
      const unsigned og = xb_add(&bar[XB_TOP], 1u);
      const unsigned tg = og / nx;
      if (og + 1u == (tg + 1u) * nx) xb_add(&bar[XB_TOPGEN], 1u);
      else XB_SPIN(xb_ld(&bar[XB_TOPGEN]) == tg, bar);
      __builtin_amdgcn_fence(__ATOMIC_ACQUIRE, "agent");
      xb_add(&bar[XB_XGEN(b.x)], 1u);
      asm volatile("s_waitcnt vmcnt(0)" ::: "memory");
    } else {
      XB_SPIN(xb_ld(&bar[XB_XGEN(b.x)]) == gen, bar);
      __builtin_amdgcn_fence(__ATOMIC_ACQUIRE, "agent");
      asm volatile("s_waitcnt vmcnt(0)" ::: "memory");
    }
  }
  __syncthreads();
}

__global__ void __launch_bounds__(512, 2) mega_fwd(Params P) {
  __shared__ __attribute__((aligned(16))) unsigned char smem[LDS_BYTES];
  __shared__ uint4 xb_words;
  cg::grid_group grid = cg::this_grid();
  if (P.ws == nullptr) grid.sync();
  if (threadIdx.x == 0) xb_words = make_uint4(0u, 0u, 0u, 0u);
  __syncthreads();
  XcdBarrier xbar = xcd_barrier_post((unsigned*)(P.ws + OFF_BAR), (volatile LAS unsigned*)&xb_words);
  const int G = gridDim.x, L = logical_bid();
  unsigned char* ws = P.ws;
  bf16_t* og = (bf16_t*)P.out;
  const bf16_t* xb = (const bf16_t*)(ws + OFF_XB);

  phase_prep(P, smem, L, G);
  xcd_barrier(xbar);

  phase_inproj_impl<false>(xb, 1024, 16, (const bf16_t*)(ws + OFF_WIN0T), 10, 0, P, smem, L, G);
  xcd_barrier(xbar);
  phase_attn_swa(P, P.l0_sinks, og, smem, L, G);
  xcd_barrier(xbar);
  phase_outproj<false>(P, 0, xb, og, smem, L, G);
  phase_inproj_impl<false>((const bf16_t*)(ws + OFF_PB) + (size_t)0 * MTOK * 256, 256, 4, (const bf16_t*)(ws + OFF_PPT) + (size_t)0 * 1024 * 256, 4, 5, P, smem, L, G);
  xcd_barrier(xbar);
  phase_gate<false>(P, 0, smem, L, G);
  xcd_barrier(xbar);
  phase_inproj_impl<false>(xb, 1024, 16, (const bf16_t*)(ws + OFF_WIN1T), 7, 1, P, smem, L, G);
  xcd_barrier(xbar);
  phase_mla_up(P, smem, L, G);
  xcd_barrier(xbar);
  phase_attn_mla(P, og, smem, L, G);
  xcd_barrier(xbar);
  phase_outproj<false>(P, 1, xb, og, smem, L, G);
  phase_inproj_impl<false>((const bf16_t*)(ws + OFF_PB) + (size_t)1 * MTOK * 256, 256, 4, (const bf16_t*)(ws + OFF_PPT) + (size_t)1 * 1024 * 256, 4, 5, P, smem, L, G);
  xcd_barrier(xbar);
  phase_gate<false>(P, 1, smem, L, G);
  xcd_barrier(xbar);
  phase_inproj_impl<false>(xb, 1024, 16, (const bf16_t*)(ws + OFF_WIN2T), 15, 2, P, smem, L, G);
  xcd_barrier(xbar);
  phase_cmp1(P, smem, L, G);
  xcd_barrier(xbar);
  phase_cmp2(P, smem, L, G);
  xcd_barrier(xbar);
  phase_attn_nsa(P, og, smem, L, G);
  xcd_barrier(xbar);
  phase_outproj<false>(P, 2, xb, og, smem, L, G);
  phase_inproj_impl<false>((const bf16_t*)(ws + OFF_PB) + (size_t)2 * MTOK * 256, 256, 4, (const bf16_t*)(ws + OFF_PPT) + (size_t)2 * 1024 * 256, 4, 5, P, smem, L, G);
  xcd_barrier(xbar);
  phase_gate<false>(P, 2, smem, L, G);
  xcd_barrier(xbar);
  phase_inproj_impl<false>(xb, 1024, 16, (const bf16_t*)(ws + OFF_WIN3T), 10, 0, P, smem, L, G);
  xcd_barrier(xbar);
  phase_attn_swa(P, P.l3_sinks, og, smem, L, G);
  xcd_barrier(xbar);
  phase_outproj<false>(P, 3, xb, og, smem, L, G);
  phase_inproj_impl<false>((const bf16_t*)(ws + OFF_PB) + (size_t)3 * MTOK * 256, 256, 4, (const bf16_t*)(ws + OFF_PPT) + (size_t)3 * 1024 * 256, 4, 5, P, smem, L, G);
  xcd_barrier(xbar);
  phase_gate<true>(P, 3, smem, L, G);
}

extern "C" void kernel_launch(void* const* d_in, const int* in_sizes, int n_in, void* d_out, int out_size, void* d_ws, size_t ws_size,
                              hipStream_t stream) {
  static int grid_blocks = 0;
  if (!grid_blocks) {
    int dev = 0, cus = 0, per_cu = 0;
    hipGetDevice(&dev);
    hipDeviceGetAttribute(&cus, hipDeviceAttributeMultiprocessorCount, dev);
    hipOccupancyMaxActiveBlocksPerMultiprocessor(&per_cu, mega_fwd, NTHR, 0);
    per_cu = 1;
    grid_blocks = cus * per_cu;
    if (ws_size < WS_NEED) fprintf(stderr, "kernel_launch: workspace too small: %zu < %zu\n", ws_size, (size_t)WS_NEED);
  }
  Params p{};
  p.x = (const float*)d_in[0]; p.p = (const float*)d_in[1]; p.pos = (const int*)d_in[2]; p.w_out = (const float*)d_in[3];
  p.ln_g = (const float*)d_in[4]; p.ln_b = (const float*)d_in[5]; p.pe_gate = (const float*)d_in[6]; p.pe_proj = (const float*)d_in[7];
  p.l0_w_in = (const float*)d_in[8]; p.l0_sinks = (const float*)d_in[9];
  p.l1_w_in = (const float*)d_in[10]; p.l1_q_norm = (const float*)d_in[11]; p.l1_kv_norm = (const float*)d_in[12];
  p.l1_w_uq = (const float*)d_in[13]; p.l1_w_ukv = (const float*)d_in[14];
  p.l2_w_in = (const float*)d_in[15]; p.l2_cmp_pos = (const float*)d_in[16]; p.l2_phi_k1 = (const float*)d_in[17]; p.l2_phi_k2 = (const float*)d_in[18];
  p.l2_phi_v1 = (const float*)d_in[19]; p.l2_phi_v2 = (const float*)d_in[20];
  p.l3_w_in = (const float*)d_in[21]; p.l3_sinks = (const float*)d_in[22];
  p.out = (float*)d_out; p.ws = (unsigned char*)d_ws;
  (void)hipMemsetAsync((unsigned char*)d_ws + OFF_BAR, 0, 16384, stream);
  void* args[] = {&p};
  hipError_t e = hipLaunchCooperativeKernel((void*)mega_fwd, dim3(grid_blocks), dim3(NTHR), args, 0, stream);
  if (e != hipSuccess) fprintf(stderr, "cooperative launch failed: %s (grid %d)\n", hipGetErrorString(e), grid_blocks);
}
```
